# Optimizing an MI355X kernel written in HIP

```python
import math
import jax, jax.numpy as jnp
from jax import lax
import numpy as np

D_MODEL = 4096
BATCH = 2
SEQ = 8192
DEPTH = 1

SSM_EXPAND = 2
D_SSM = SSM_EXPAND * D_MODEL
SSM_HEADDIM = 64
SSM_HEADS = D_SSM // SSM_HEADDIM
SSM_GROUPS = 8
SSM_STATE = 128
CONV_WIDTH = 4
CHUNK = 128
D_CONV = D_SSM + 2 * SSM_GROUPS * SSM_STATE

MLA_HEADS = 32
QK_NOPE = 128
QK_ROPE = 64
V_HEAD = 128
Q_LORA = 1024
KV_LORA = 512
D_ATTN = MLA_HEADS * V_HEAD
ROPE_THETA = 10000.0
Q_BLOCK = 128

EPS = 1e-6

IN_SIZES = (D_SSM, D_CONV, SSM_HEADS, Q_LORA, KV_LORA + QK_ROPE, D_ATTN, D_MODEL, D_MODEL)
D_IN = D_SSM + D_CONV + SSM_HEADS + Q_LORA + KV_LORA + QK_ROPE + D_ATTN + 2 * D_MODEL

kernel_name = "hybrid_ssd_mla_gated_merge"


def rmsnorm(x, w):
    xf = x.astype(jnp.float32)
    xf = xf * lax.rsqrt(jnp.mean(xf * xf, axis=-1, keepdims=True) + EPS)
    return xf.astype(x.dtype) * w


def causal_depthwise_conv(u, w, b):
    L = u.shape[1]
    up = jnp.pad(u, ((0, 0), (CONV_WIDTH - 1, 0), (0, 0)))
    out = b
    for k in range(CONV_WIDTH):
        out = out + up[:, k:k + L] * w[k]
    return out


def rope(x, pos):
    half = x.shape[-1] // 2
    inv_freq = ROPE_THETA ** (-jnp.arange(0, half, dtype=jnp.float32) / half)
    ang = pos.astype(jnp.float32)[:, None] * inv_freq[None, :]
    cos = jnp.cos(ang)[None, :, None, :]
    sin = jnp.sin(ang)[None, :, None, :]
    xf = x.astype(jnp.float32)
    x1, x2 = xf[..., :half], xf[..., half:]
    out = jnp.concatenate([x1 * cos - x2 * sin, x2 * cos + x1 * sin], axis=-1)
    return out.astype(x.dtype)


def ssd_chunked(x, dt, A, Bm, Cm):
    b, L = x.shape[:2]
    c = L // CHUNK
    r = SSM_HEADS // SSM_GROUPS
    G, N, P = SSM_GROUPS, SSM_STATE, SSM_HEADDIM
    xdt = (x.astype(jnp.float32) * dt[..., None]).reshape(b, c, CHUNK, G, r, P)
    a = (dt * A).reshape(b, c, CHUNK, G, r)
    Bc = Bm.astype(jnp.float32).reshape(b, c, CHUNK, G, N)
    Cc = Cm.astype(jnp.float32).reshape(b, c, CHUNK, G, N)
    a_cs = jnp.cumsum(a, axis=2)
    seg = a_cs[:, :, :, None] - a_cs[:, :, None]
    causal = jnp.tril(jnp.ones((CHUNK, CHUNK), dtype=bool))[None, None, :, :, None, None]
    decay = jnp.exp(jnp.where(causal, seg, -jnp.inf))
    cb = jnp.einsum("bclgn,bcsgn->bclsg", Cc, Bc)
    scores = cb[..., None] * decay
    y_diag = jnp.einsum("bclsgr,bcsgrp->bclgrp", scores, xdt)
    decay_states = jnp.exp(a_cs[:, :, -1:] - a_cs)
    states = jnp.einsum("bclgn,bclgrp->bcgrpn", Bc, xdt * decay_states[..., None])
    chunk_decay = jnp.exp(a_cs[:, :, -1])

    def step(h, inp):
        s, d = inp
        return h * d[..., None, None] + s, h

    h0 = jnp.zeros((b, G, r, P, N), jnp.float32)
    _, prev = lax.scan(step, h0, (jnp.moveaxis(states, 1, 0), jnp.moveaxis(chunk_decay, 1, 0)))
    prev = jnp.moveaxis(prev, 0, 1)
    y_off = jnp.einsum("bclgn,bcgrpn->bclgrp", Cc, prev) * jnp.exp(a_cs)[..., None]
    return (y_diag + y_off).reshape(b, L, SSM_HEADS, P)


def gated_group_rmsnorm(y, z, w):
    b, L, _ = y.shape
    g = (y.astype(jnp.float32) * jax.nn.silu(z.astype(jnp.float32))).reshape(b, L, SSM_GROUPS, D_SSM // SSM_GROUPS)
    g = g * lax.rsqrt(jnp.mean(g * g, axis=-1, keepdims=True) + EPS)
    return g.reshape(b, L, D_SSM).astype(y.dtype) * w


def mla(cq_raw, kv_raw, q_norm_w, w_uq, kv_norm_w, w_ukv, pos):
    b, L = cq_raw.shape[:2]
    cq = rmsnorm(cq_raw, q_norm_w)
    q = (cq @ w_uq).reshape(b, L, MLA_HEADS, QK_NOPE + QK_ROPE)
    q_nope = q[..., :QK_NOPE]
    q_rope = rope(q[..., QK_NOPE:], pos)
    ckv = rmsnorm(kv_raw[..., :KV_LORA], kv_norm_w)
    k_rope = rope(kv_raw[..., KV_LORA:][:, :, None, :], pos)[:, :, 0]
    kv = (ckv @ w_ukv).reshape(b, L, MLA_HEADS, QK_NOPE + V_HEAD)
    k_nope, v = kv[..., :QK_NOPE], kv[..., QK_NOPE:]
    scale = 1.0 / math.sqrt(QK_NOPE + QK_ROPE)
    nb = L // Q_BLOCK
    qn = q_nope.reshape(b, nb, Q_BLOCK, MLA_HEADS, QK_NOPE).swapaxes(0, 1)
    qr = q_rope.reshape(b, nb, Q_BLOCK, MLA_HEADS, QK_ROPE).swapaxes(0, 1)
    kpos = pos

    def block(args):
        qn_i, qr_i, i = args
        s = jnp.einsum("bqhd,bkhd->bhqk", qn_i, k_nope) + jnp.einsum("bqhr,bkr->bhqk", qr_i, k_rope)
        s = s.astype(jnp.float32) * scale
        qpos = lax.dynamic_slice_in_dim(pos, i * Q_BLOCK, Q_BLOCK)
        mask = kpos[None, :] <= qpos[:, None]
        s = jnp.where(mask[None, None], s, -jnp.inf)
        p = jax.nn.softmax(s, axis=-1).astype(v.dtype)
        return jnp.einsum("bhqk,bkhd->bqhd", p, v)

    o = lax.map(block, (qn, qr, jnp.arange(nb)))
    return o.swapaxes(0, 1).reshape(b, L, D_ATTN)


def setup_inputs(seed: int = 0) -> dict:
    key = jax.random.key(seed)
    ks = jax.random.split(key, 20)
    f32 = jnp.float32

    def lin(k, fan_in, fan_out):
        return jax.random.normal(k, (DEPTH, fan_in, fan_out), f32) * fan_in ** -0.5

    def gain(k, n):
        return 1.0 + 0.02 * jax.random.normal(k, (DEPTH, n), f32)

    dt0 = jnp.exp(jax.random.uniform(ks[5], (DEPTH, SSM_HEADS), f32, math.log(1e-3), math.log(1e-1)))
    dt_bias = dt0 + jnp.log(-jnp.expm1(-dt0))
    a_log = jnp.log(jax.random.uniform(ks[6], (DEPTH, SSM_HEADS), f32, 1.0, 16.0))
    return {
        "x": jax.random.normal(ks[0], (BATCH, SEQ, D_MODEL), f32),
        "norm_in_w": gain(ks[1], D_MODEL),
        "w_in": lin(ks[2], D_MODEL, D_IN),
        "conv_w": jax.random.normal(ks[3], (DEPTH, CONV_WIDTH, D_CONV), f32) * CONV_WIDTH ** -0.5,
        "conv_b": 0.01 * jax.random.normal(ks[4], (DEPTH, D_CONV), f32),
        "dt_bias": dt_bias,
        "a_log": a_log,
        "d_skip": 1.0 + 0.1 * jax.random.normal(ks[7], (DEPTH, SSM_HEADS), f32),
        "ssm_norm_w": gain(ks[8], D_SSM),
        "q_norm_w": gain(ks[9], Q_LORA),
        "w_uq": lin(ks[10], Q_LORA, MLA_HEADS * (QK_NOPE + QK_ROPE)),
        "kv_norm_w": gain(ks[11], KV_LORA),
        "w_ukv": lin(ks[12], KV_LORA, MLA_HEADS * (QK_NOPE + V_HEAD)),
        "w_branch_ssm": lin(ks[13], D_SSM, D_MODEL),
        "w_branch_attn": lin(ks[14], D_ATTN, D_MODEL),
        "w_out": lin(ks[15], D_MODEL, D_MODEL),
        "norm_final_w": 1.0 + 0.02 * jax.random.normal(ks[16], (D_MODEL,), f32),
    }


def reference(x, norm_in_w, w_in, conv_w, conv_b, dt_bias, a_log, d_skip, ssm_norm_w,
              q_norm_w, w_uq, kv_norm_w, w_ukv, w_branch_ssm, w_branch_attn, w_out, norm_final_w):
    b, L, _ = x.shape
    pos = jnp.arange(L, dtype=jnp.int32)
    splits = tuple(int(s) for s in np.cumsum(IN_SIZES)[:-1])
    h = x
    for layer in range(DEPTH):
        u = rmsnorm(h, norm_in_w[layer])
        proj = u @ w_in[layer]
        z, xbc, dt_raw, cq_raw, kv_raw, g_attn, gate_ssm, gate_attn = jnp.split(proj, splits, axis=-1)

        xbc = jax.nn.silu(causal_depthwise_conv(xbc, conv_w[layer], conv_b[layer]))
        xs = xbc[..., :D_SSM]
        Bm = xbc[..., D_SSM:D_SSM + SSM_GROUPS * SSM_STATE].reshape(b, L, SSM_GROUPS, SSM_STATE)
        Cm = xbc[..., D_SSM + SSM_GROUPS * SSM_STATE:].reshape(b, L, SSM_GROUPS, SSM_STATE)
        dt = jax.nn.softplus(dt_raw.astype(jnp.float32) + dt_bias[layer].astype(jnp.float32))
        A = -jnp.exp(a_log[layer].astype(jnp.float32))
        xh = xs.reshape(b, L, SSM_HEADS, SSM_HEADDIM)
        y = ssd_chunked(xh, dt, A, Bm, Cm) + xh.astype(jnp.float32) * d_skip[layer].astype(jnp.float32)[:, None]
        y_ssm = gated_group_rmsnorm(y.astype(x.dtype).reshape(b, L, D_SSM), z, ssm_norm_w[layer])

        o = mla(cq_raw, kv_raw, q_norm_w[layer], w_uq[layer], kv_norm_w[layer], w_ukv[layer], pos)
        y_attn = o * jax.nn.silu(g_attn)

        merged = (jax.nn.sigmoid(gate_ssm) * (y_ssm @ w_branch_ssm[layer])
                  + jax.nn.sigmoid(gate_attn) * (y_attn @ w_branch_attn[layer]))
        h = h + merged @ w_out[layer]
    return rmsnorm(h, norm_final_w)
```

```cpp
#include <hip/hip_runtime.h>
#include <cstdio>
#include <cstdint>

#ifndef MK_DEBUG
#define MK_DEBUG 0
#endif

namespace pg8 {
#define PG8_LAS __attribute__((address_space(3)))
typedef unsigned short bf16_t;
typedef short bf16x8 __attribute__((ext_vector_type(8)));
typedef float f32x4 __attribute__((ext_vector_type(4)));
typedef unsigned u32x4 __attribute__((ext_vector_type(4)));
typedef int v4i_t __attribute__((ext_vector_type(4)));
constexpr int BM = 256, BK = 64, HALF = 128, HTB = HALF * BK * 2, STAGE_BYTES = 8 * HTB, NXCD = 8, WGM = 8;

__host__ __device__ __forceinline__ int lds_byte(int r, int c) { const int st = (r >> 4) * 2 + (c >> 5), rr = r & 15, cc = c & 31, ob = rr * 64 + cc * 2; return st * 1024 + (ob ^ (((ob >> 9) & 1) << 5)); }
__host__ __device__ __forceinline__ void stage_rc(int b, int& R, int& C) { const int st = b / 1024, sb = b % 1024, swz = sb ^ (((sb >> 9) & 1) << 5); R = (st >> 1) * 16 + swz / 64; C = (st & 1) * 32 + (swz % 64) / 2; }
__host__ __device__ __forceinline__ int perm32(int rho) { const int n = rho >> 4, i = rho & 15; return 8 * (i >> 2) + 4 * n + (i & 3); }

struct Unit { int pm, pn; };
struct Gemm { const bf16_t* A; const bf16_t* Bt; int M, N, K, lda, ldb; int sX = 0x7F7F7F7F, sW = 0x7F7F7F7F; };

struct StaticOrder {
    int nM, nN, nwg, G, c;
    __host__ __device__ void init(int M, int N, int G_, int c_) { nM = M / BM; nN = N / BM; nwg = nM * nN; G = G_; c = c_; }
    __host__ __device__ bool next(int i, Unit& u) const {
        const long L = (long)i * G + c; if (L >= nwg) return false;
        int wgid = (int)L; { const int q = nwg / NXCD, r = nwg % NXCD, xcd = wgid % NXCD, off = wgid / NXCD; wgid = (xcd < r ? xcd * (q + 1) : r * (q + 1) + (xcd - r) * q) + off; }
        const int nig = WGM * nN, gid = wgid / nig, fm = gid * WGM, gsz = (nM - fm) < WGM ? (nM - fm) : WGM;
        u.pm = fm + ((wgid % nig) % gsz); u.pn = (wgid % nig) / gsz; return true;
    }
    __device__ __forceinline__ void a_ready(const Unit&) const {}
    __device__ __forceinline__ void done(const Unit&) const {}
};

struct SyncedOrder : StaticOrder {
    unsigned* cnt; int per_xcd; int nfull;
    mutable int k;
    __device__ __forceinline__ void a_ready(const Unit&) const {
        const int kk = k; k = kk + 1;
        if (kk == 0 || kk >= nfull) return;
        if (threadIdx.x == 0) {
            __hip_atomic_fetch_add(cnt, 1u, __ATOMIC_RELAXED, __HIP_MEMORY_SCOPE_AGENT);
            const unsigned want = (unsigned)(per_xcd * kk); unsigned sp = 0;
            while (__hip_atomic_load(cnt, __ATOMIC_RELAXED, __HIP_MEMORY_SCOPE_AGENT) < want) { __builtin_amdgcn_s_sleep(1); if (++sp > (1u << 14)) break; }
        }
        asm volatile("" ::: "memory"); __builtin_amdgcn_s_barrier(); asm volatile("" ::: "memory");
    }
};

typedef float f32x2c_t __attribute__((ext_vector_type(2))); typedef __bf16 bf16x2c_t __attribute__((ext_vector_type(2)));
__device__ __forceinline__ unsigned cvt_pk_bf16(float lo, float hi) { f32x2c_t v = {lo, hi}; bf16x2c_t b = __builtin_convertvector(v, bf16x2c_t); return __builtin_bit_cast(unsigned, b); }
__device__ __forceinline__ float bf_lo(unsigned w) { return __uint_as_float(w << 16); }
__device__ __forceinline__ float bf_hi(unsigned w) { return __uint_as_float(w & 0xffff0000u); }
__device__ __forceinline__ float sigmoidf_(float x) { return __builtin_amdgcn_rcpf(1.0f + __expf(-x)); }

#define EPI_LOOP_BEGIN  _Pragma("unroll") for (int ai = 0; ai < 2; ++ai) _Pragma("unroll") for (int m = 0; m < 4; ++m) { const int row = row0 + ai * HALF + m * 16; _Pragma("unroll") for (int bj = 0; bj < 2; ++bj) { \
        f32x4 v0 = acc[ai][bj][m][0], v1 = acc[ai][bj][m][1]; const int col = col0 + bj * HALF;
#define EPI_LOOP_END } }
#define EPI_PACK(w, v0, v1) u32x4 w; w.x = cvt_pk_bf16(v0[0], v0[1]); w.y = cvt_pk_bf16(v0[2], v0[3]); w.z = cvt_pk_bf16(v1[0], v1[1]); w.w = cvt_pk_bf16(v1[2], v1[3]);

struct EpiProj {
    static constexpr bool PERM = true;
    bf16_t* O; int ldc; float* dt32; int dt_pn;
    __device__ __forceinline__ void operator()(const f32x4 (&acc)[2][2][4][2], const Unit& u, int wr, int wc, int fr, int fq) const {
        const int row0 = u.pm * BM + wr * 64 + fr, col0 = u.pn * BM + wc * 32 + 8 * fq; const bool isdt = (u.pn == dt_pn);
        EPI_LOOP_BEGIN
            if (!isdt) { EPI_PACK(w, v0, v1); *(u32x4*)(O + (size_t)row * ldc + col) = w; }
            else if (bj == 0) { float* d = dt32 + (size_t)row * 128 + wc * 32 + 8 * fq; *(f32x4*)d = v0; *(f32x4*)(d + 4) = v1; }
        EPI_LOOP_END
    }
};
struct EpiQ {
    static constexpr bool PERM = true;
    bf16_t* QN; bf16_t* QR; const float* rstd; const float* COS; const float* SIN;
    __device__ __forceinline__ void operator()(const f32x4 (&acc)[2][2][4][2], const Unit& u, int wr, int wc, int fr, int fq) const {
        const int row0 = u.pm * BM + wr * 64 + fr, col0 = u.pn * BM + wc * 32 + 8 * fq; const bool rope = (u.pn >= 16);
        EPI_LOOP_BEGIN
            const float rs = rstd[row]; v0 = v0 * rs; v1 = v1 * rs;
            if (!rope) { EPI_PACK(w, v0, v1); *(u32x4*)(QN + (size_t)row * 4096 + col) = w; }
            else { const int cr = col - 4096, i0 = (cr & 63) >> 1, pos = row & 8191;
                const f32x4 c = *(const f32x4*)(COS + pos * 32 + i0), s = *(const f32x4*)(SIN + pos * 32 + i0);
                f32x4 o0, o1;
                o0[0] = v0[0] * c[0] - v0[1] * s[0]; o0[1] = v0[1] * c[0] + v0[0] * s[0]; o0[2] = v0[2] * c[1] - v0[3] * s[1]; o0[3] = v0[3] * c[1] + v0[2] * s[1];
                o1[0] = v1[0] * c[2] - v1[1] * s[2]; o1[1] = v1[1] * c[2] + v1[0] * s[2]; o1[2] = v1[2] * c[3] - v1[3] * s[3]; o1[3] = v1[3] * c[3] + v1[2] * s[3];
                EPI_PACK(w, o0, o1); *(u32x4*)(QR + (size_t)row * 2048 + cr) = w; }
        EPI_LOOP_END
    }
};
__device__ __forceinline__ unsigned pk4_fp8(float a, float b, float c, float d) { int w = __builtin_amdgcn_cvt_pk_fp8_f32(a, b, 0, false); w = __builtin_amdgcn_cvt_pk_fp8_f32(c, d, w, true); return (unsigned)w; }
typedef unsigned u32x2 __attribute__((ext_vector_type(2)));
struct EpiProj8 {
    static constexpr bool PERM = true;
    bf16_t* O; int ldc; unsigned char* cq8; unsigned char* kv8; int cq_pn, kv_pn;
    __device__ __forceinline__ void operator()(const f32x4 (&acc)[2][2][4][2], const Unit& u, int wr, int wc, int fr, int fq) const {
        const int row0 = u.pm * BM + wr * 64 + fr, col0 = u.pn * BM + wc * 32 + 8 * fq; const bool iscq = (u.pn >= cq_pn && u.pn < cq_pn + 4), iskv = (u.pn == kv_pn || u.pn == kv_pn + 1);
        EPI_LOOP_BEGIN
            EPI_PACK(w, v0, v1); *(u32x4*)(O + (size_t)row * ldc + col) = w;
            if (iscq || iskv) { u32x2 w8; w8.x = pk4_fp8(v0[0], v0[1], v0[2], v0[3]); w8.y = pk4_fp8(v1[0], v1[1], v1[2], v1[3]);
                if (iscq) *(u32x2*)(cq8 + (size_t)row * 1024 + (col - cq_pn * BM)) = w8; else *(u32x2*)(kv8 + (size_t)row * 512 + (col - kv_pn * BM)) = w8; }
        EPI_LOOP_END
    }
};
struct EpiQ8 {
    static constexpr bool PERM = true;
    unsigned char* QN; unsigned char* QR; const float* rstd; const float* COS; const float* SIN;
    __device__ __forceinline__ void operator()(const f32x4 (&acc)[2][2][4][2], const Unit& u, int wr, int wc, int fr, int fq) const {
        const int row0 = u.pm * BM + wr * 64 + fr, col0 = u.pn * BM + wc * 32 + 8 * fq; const bool rope = (u.pn >= 16);
        const int cr0 = col0 - 4096, i0 = (cr0 & 63) >> 1;
#pragma unroll
        for (int am = 0; am < 4; ++am) {
            const int ai = am >> 1;
            float rs[2]; f32x4 cq[2], sq[2];
#pragma unroll
            for (int mm = 0; mm < 2; ++mm) { const int row = row0 + ai * HALF + (2 * (am & 1) + mm) * 16; rs[mm] = rstd[row];
                if (rope) { const int pos = row & 8191; cq[mm] = *(const f32x4*)(COS + pos * 32 + i0); sq[mm] = *(const f32x4*)(SIN + pos * 32 + i0); } }
            asm volatile("" : "+v"(rs[0]), "+v"(rs[1]));
            if (rope) asm volatile("" : "+v"(cq[0]), "+v"(cq[1]), "+v"(sq[0]), "+v"(sq[1]));
#pragma unroll
            for (int mm = 0; mm < 2; ++mm)
#pragma unroll
                for (int bj = 0; bj < 2; ++bj) { const int m = 2 * (am & 1) + mm, row = row0 + ai * HALF + m * 16, col = col0 + bj * HALF;
                    f32x4 v0 = acc[ai][bj][m][0] * rs[mm], v1 = acc[ai][bj][m][1] * rs[mm];
                    if (!rope) { u32x2 w; w.x = pk4_fp8(v0[0], v0[1], v0[2], v0[3]); w.y = pk4_fp8(v1[0], v1[1], v1[2], v1[3]); *(u32x2*)(QN + (size_t)row * 4096 + col) = w; }
                    else { const int cr = col - 4096; const f32x4 c = cq[mm], s_ = sq[mm];
                        f32x4 o0, o1;
                        o0[0] = v0[0] * c[0] - v0[1] * s_[0]; o0[1] = v0[1] * c[0] + v0[0] * s_[0]; o0[2] = v0[2] * c[1] - v0[3] * s_[1]; o0[3] = v0[3] * c[1] + v0[2] * s_[1];
                        o1[0] = v1[0] * c[2] - v1[1] * s_[2]; o1[1] = v1[1] * c[2] + v1[0] * s_[2]; o1[2] = v1[2] * c[3] - v1[3] * s_[3]; o1[3] = v1[3] * c[3] + v1[2] * s_[3];
                        u32x2 w; w.x = pk4_fp8(o0[0], o0[1], o0[2], o0[3]); w.y = pk4_fp8(o1[0], o1[1], o1[2], o1[3]); *(u32x2*)(QR + (size_t)row * 2048 + cr) = w; } }
        }
    }
};
struct EpiK8 {
    static constexpr bool PERM = true;
    unsigned char* K8; const float* rstd;
    __device__ __forceinline__ void operator()(const f32x4 (&acc)[2][2][4][2], const Unit& u, int wr, int wc, int fr, int fq) const {
        const int row0 = u.pm * BM + wr * 64 + fr, col0 = u.pn * BM + wc * 32 + 8 * fq;
        float rs[2][4];
#pragma unroll
        for (int ai = 0; ai < 2; ++ai)
#pragma unroll
            for (int m = 0; m < 4; ++m) rs[ai][m] = rstd[row0 + ai * HALF + m * 16];
        asm volatile("" : "+v"(rs[0][0]), "+v"(rs[0][1]), "+v"(rs[0][2]), "+v"(rs[0][3]), "+v"(rs[1][0]), "+v"(rs[1][1]), "+v"(rs[1][2]), "+v"(rs[1][3]));
        EPI_LOOP_BEGIN
            v0 = v0 * rs[ai][m]; v1 = v1 * rs[ai][m];
            u32x2 w; w.x = pk4_fp8(v0[0], v0[1], v0[2], v0[3]); w.y = pk4_fp8(v1[0], v1[1], v1[2], v1[3]); *(u32x2*)(K8 + (size_t)row * 4096 + col) = w;
        EPI_LOOP_END
    }
};
struct EpiVT8 {
    static constexpr bool PERM = true;
    unsigned char* VT; const float* rstd;
    __device__ __forceinline__ void operator()(const f32x4 (&acc)[2][2][4][2], const Unit& u, int wr, int wc, int fr, int fq) const {
        const int row0 = u.pm * BM + wr * 64 + fr, col0 = u.pn * BM + wc * 32 + 8 * fq;
        f32x4 r0[2], r1[2];
#pragma unroll
        for (int bj = 0; bj < 2; ++bj) { r0[bj] = *(const f32x4*)(rstd + col0 + bj * HALF); r1[bj] = *(const f32x4*)(rstd + col0 + bj * HALF + 4); }
        EPI_LOOP_BEGIN
            v0 = v0 * r0[bj]; v1 = v1 * r1[bj];
            const int bb = col >> 13, t = col & 8191, k64 = t & 63;
            unsigned char* p = VT + ((size_t)(bb * 4096 + row) * 8192) + (t & ~63) + 16 * (k64 >> 5) + 4 * ((k64 >> 3) & 3);
            *(unsigned*)p = pk4_fp8(v0[0], v0[1], v0[2], v0[3]); *(unsigned*)(p + 32) = pk4_fp8(v1[0], v1[1], v1[2], v1[3]);
        EPI_LOOP_END
    }
};
struct EpiKV {
    static constexpr bool PERM = true;
    bf16_t* KV; const float* rstd;
    __device__ __forceinline__ void operator()(const f32x4 (&acc)[2][2][4][2], const Unit& u, int wr, int wc, int fr, int fq) const {
        const int row0 = u.pm * BM + wr * 64 + fr, col0 = u.pn * BM + wc * 32 + 8 * fq;
        EPI_LOOP_BEGIN
            const float rs = rstd[row]; v0 = v0 * rs; v1 = v1 * rs;
            EPI_PACK(w, v0, v1); *(u32x4*)(KV + (size_t)row * 8192 + col) = w;
        EPI_LOOP_END
    }
};
template <bool ADD> struct EpiGate {
    static constexpr bool PERM = true;
    bf16_t* T; const bf16_t* gate; int ldg;
    __device__ __forceinline__ void operator()(const f32x4 (&acc)[2][2][4][2], const Unit& u, int wr, int wc, int fr, int fq) const {
        const int row0 = u.pm * BM + wr * 64 + fr, col0 = u.pn * BM + wc * 32 + 8 * fq;
#pragma unroll
        for (int ai = 0; ai < 2; ++ai) {
            u32x4 gq[4][2], tq[4][2];
#pragma unroll
            for (int m = 0; m < 4; ++m)
#pragma unroll
                for (int bj = 0; bj < 2; ++bj) { const size_t row = (size_t)(row0 + ai * HALF + m * 16); const int col = col0 + bj * HALF;
                    gq[m][bj] = *(const u32x4*)(gate + row * ldg + col); if (ADD) tq[m][bj] = *(const u32x4*)(T + row * 4096 + col); }
            asm volatile("" : "+v"(gq[0][0]), "+v"(gq[0][1]), "+v"(gq[1][0]), "+v"(gq[1][1]), "+v"(gq[2][0]), "+v"(gq[2][1]), "+v"(gq[3][0]), "+v"(gq[3][1]));
            if (ADD) asm volatile("" : "+v"(tq[0][0]), "+v"(tq[0][1]), "+v"(tq[1][0]), "+v"(tq[1][1]), "+v"(tq[2][0]), "+v"(tq[2][1]), "+v"(tq[3][0]), "+v"(tq[3][1]));
#pragma unroll
            for (int m = 0; m < 4; ++m)
#pragma unroll
                for (int bj = 0; bj < 2; ++bj) { const size_t row = (size_t)(row0 + ai * HALF + m * 16); const int col = col0 + bj * HALF;
                    f32x4 v0 = acc[ai][bj][m][0], v1 = acc[ai][bj][m][1]; const u32x4 g = gq[m][bj];
                    v0[0] *= sigmoidf_(bf_lo(g.x)); v0[1] *= sigmoidf_(bf_hi(g.x)); v0[2] *= sigmoidf_(bf_lo(g.y)); v0[3] *= sigmoidf_(bf_hi(g.y));
                    v1[0] *= sigmoidf_(bf_lo(g.z)); v1[1] *= sigmoidf_(bf_hi(g.z)); v1[2] *= sigmoidf_(bf_lo(g.w)); v1[3] *= sigmoidf_(bf_hi(g.w));
                    if (ADD) { const u32x4 t = tq[m][bj];
                        v0[0] += bf_lo(t.x); v0[1] += bf_hi(t.x); v0[2] += bf_lo(t.y); v0[3] += bf_hi(t.y); v1[0] += bf_lo(t.z); v1[1] += bf_hi(t.z); v1[2] += bf_lo(t.w); v1[3] += bf_hi(t.w); }
                    EPI_PACK(w, v0, v1); *(u32x4*)(T + row * 4096 + col) = w; }
        }
    }
};
struct EpiOut {
    static constexpr bool PERM = true;
    bf16_t* out; const float* x;
    __device__ __forceinline__ void operator()(const f32x4 (&acc)[2][2][4][2], const Unit& u, int wr, int wc, int fr, int fq) const {
        const int row0 = u.pm * BM + wr * 64 + fr, col0 = u.pn * BM + wc * 32 + 8 * fq;
#pragma unroll
        for (int ai = 0; ai < 2; ++ai) {
            f32x4 xa[4][2], xb[4][2];
#pragma unroll
            for (int m = 0; m < 4; ++m)
#pragma unroll
                for (int bj = 0; bj < 2; ++bj) { const size_t o = (size_t)(row0 + ai * HALF + m * 16) * 4096 + col0 + bj * HALF; xa[m][bj] = *(const f32x4*)(x + o); xb[m][bj] = *(const f32x4*)(x + o + 4); }
            asm volatile("" : "+v"(xa[0][0]), "+v"(xa[0][1]), "+v"(xa[1][0]), "+v"(xa[1][1]), "+v"(xa[2][0]), "+v"(xa[2][1]), "+v"(xa[3][0]), "+v"(xa[3][1]));
            asm volatile("" : "+v"(xb[0][0]), "+v"(xb[0][1]), "+v"(xb[1][0]), "+v"(xb[1][1]), "+v"(xb[2][0]), "+v"(xb[2][1]), "+v"(xb[3][0]), "+v"(xb[3][1]));
#pragma unroll
            for (int m = 0; m < 4; ++m)
#pragma unroll
                for (int bj = 0; bj < 2; ++bj) { const size_t o = (size_t)(row0 + ai * HALF + m * 16) * 4096 + col0 + bj * HALF;
                    f32x4 v0 = acc[ai][bj][m][0] + xa[m][bj], v1 = acc[ai][bj][m][1] + xb[m][bj];
                    EPI_PACK(w, v0, v1); *(u32x4*)(out + o) = w; }
        }
    }
};

template <class Epi, class Sched, int PROBE = 0, bool SP2 = true, bool FP8 = false>
__device__ __forceinline__ void gemm_phase(PG8_LAS unsigned char* lds, const Gemm g, const Sched& S, const Epi& E) {
    const int tid = threadIdx.x, wid = __builtin_amdgcn_readfirstlane(tid >> 6), lane = tid & 63, wr = wid >> 2, wc = wid & 3, fr = lane & 15, fq = lane >> 4;
    const int K = g.K, nt = K / BK;
    unsigned voffA[2], voffB[2];
#pragma unroll
    for (int i = 0; i < 2; ++i) { int R, C; stage_rc(tid * 16 + i * 8192, R, C); const int Rb = Epi::PERM ? ((R & ~31) + perm32(R & 31)) : R;
        voffA[i] = (unsigned)(R * g.lda + C) * 2u; voffB[i] = (unsigned)(Rb * g.ldb + C) * 2u; }
    const size_t kstep = (size_t)(BK * 2);
    const size_t hstepA = (size_t)HALF * g.lda * 2, hstepB = (size_t)HALF * g.ldb * 2;
    const size_t tstepA = 2 * hstepA, tstepB = 2 * hstepB;
    const unsigned ldsw = (unsigned)wid * 1024u;
    const int aoff = lds_byte(wr * 64 + fr, fq * 8), boff = lds_byte(wc * 32 + fr, fq * 8);
#define PG8_SA(b, h) (((b) * 2 + (h)) * HTB)
#define PG8_SB(b, h) ((4 + (b) * 2 + (h)) * HTB)
#define PG8_STAGE(bufoff, gbase, voff) do { if (PROBE != 1) _Pragma("unroll") for (int _i = 0; _i < 2; ++_i) \
        __builtin_amdgcn_global_load_lds((const unsigned*)((const char*)(PROBE == 3 ? (const char*)g.A : (const char*)(gbase)) + (voff)[_i]), (PG8_LAS unsigned*)(lds + (bufoff) + ldsw + _i * 8192), 16, 0, 0); } while (0)
#define PG8_CAT(x, y) __builtin_shufflevector(__builtin_bit_cast(v4i_t, x), __builtin_bit_cast(v4i_t, y), 0, 1, 2, 3, 4, 5, 6, 7)
#define PG8_LDA(dst, b, h) do { _Pragma("unroll") for (int m = 0; m < 4; ++m) { \
        if constexpr (FP8) { A8[m].lo = *(const PG8_LAS v4i_t*)(lds + PG8_SA(b, h) + aoff + m * 2048); A8[m].hi = *(const PG8_LAS v4i_t*)(lds + PG8_SA(b, h) + aoff + m * 2048 + 1024); } \
        else { _Pragma("unroll") for (int k = 0; k < 2; ++k) dst[m][k] = *(const PG8_LAS bf16x8*)(lds + PG8_SA(b, h) + aoff + m * 2048 + k * 1024); } } } while (0)
#define PG8_LDB(dst, b, h) do { _Pragma("unroll") for (int n = 0; n < 2; ++n) { \
        if constexpr (FP8) { dst##8[n].lo = *(const PG8_LAS v4i_t*)(lds + PG8_SB(b, h) + boff + n * 2048); dst##8[n].hi = *(const PG8_LAS v4i_t*)(lds + PG8_SB(b, h) + boff + n * 2048 + 1024); } \
        else { _Pragma("unroll") for (int k = 0; k < 2; ++k) dst[n][k] = *(const PG8_LAS bf16x8*)(lds + PG8_SB(b, h) + boff + n * 2048 + k * 1024); } } } while (0)
#define PG8_MMA(ai, bj, At, Bt) do { __builtin_amdgcn_s_setprio(1); \
        if constexpr (FP8) { _Pragma("unroll") for (int m = 0; m < 4; ++m) _Pragma("unroll") for (int n = 0; n < 2; ++n) \
            asm volatile("v_mfma_scale_f32_16x16x128_f8f6f4 %0, %1, %2, %0, %3, %4 op_sel_hi:[0,0,0]" : "+v"(acc[ai][bj][m][n]) : "v"(Bt##8[n]), "v"(A8[m]), "v"(sWv), "v"(sXv)); } \
        else { _Pragma("unroll") for (int m = 0; m < 4; ++m) _Pragma("unroll") for (int n = 0; n < 2; ++n) _Pragma("unroll") for (int k = 0; k < 2; ++k) \
        acc[ai][bj][m][n] = __builtin_amdgcn_mfma_f32_16x16x32_bf16(Bt[n][k], At[m][k], acc[ai][bj][m][n], 0, 0, 0); } __builtin_amdgcn_s_setprio(0); } while (0)
#define PG8_WAIT_V(n) asm volatile("s_waitcnt vmcnt(" #n ")" ::: "memory")
#define PG8_WAIT_L(n) asm volatile("s_waitcnt lgkmcnt(" #n ")" ::: "memory")
#define PG8_BAR __builtin_amdgcn_s_barrier()
#define PG8_SCHED __builtin_amdgcn_sched_barrier(0)
    Unit cur, nxt; int ui = 0;
    if (!S.next(0, cur)) return;
    f32x4 acc[2][2][4][2];
#pragma unroll
    for (int a = 0; a < 2; ++a)
#pragma unroll
        for (int b = 0; b < 2; ++b)
#pragma unroll
            for (int m = 0; m < 4; ++m)
#pragma unroll
                for (int n = 0; n < 2; ++n) acc[a][b][m][n] = (f32x4){0.f, 0.f, 0.f, 0.f};
    bf16x8 At[4][2], B0[2][2], B1[2][2];
    typedef int v8i_t __attribute__((ext_vector_type(8))); v8i_t A8[4], B08[2], B18[2];
    static_assert(!FP8 || SP2, "the fp8 form exists for the SP2 loop only");
    const int sWv = g.sW, sXv = g.sX;
    const char* cA = (const char*)g.A + (size_t)cur.pm * tstepA; const char* cB = (const char*)g.Bt + (size_t)cur.pn * tstepB;
    S.a_ready(cur);
    if constexpr (SP2) {
    PG8_STAGE(PG8_SB(0, 0), cB, voffB); PG8_STAGE(PG8_SB(0, 1), cB + hstepB, voffB); PG8_STAGE(PG8_SA(0, 0), cA, voffA); PG8_STAGE(PG8_SA(0, 1), cA + hstepA, voffA);
    if (wr == 1) PG8_BAR;
    PG8_WAIT_V(2); PG8_BAR;
    PG8_STAGE(PG8_SB(1, 0), cB + kstep, voffB); PG8_STAGE(PG8_SA(1, 0), cA + kstep, voffA); PG8_STAGE(PG8_SB(1, 1), cB + hstepB + kstep, voffB);
    PG8_WAIT_V(6); PG8_BAR;
    } else {
    PG8_STAGE(PG8_SB(0, 0), cB, voffB); PG8_STAGE(PG8_SA(0, 0), cA, voffA); PG8_STAGE(PG8_SB(0, 1), cB + hstepB, voffB); PG8_STAGE(PG8_SA(0, 1), cA + hstepA, voffA);
    if (wr == 1) PG8_BAR;
    PG8_WAIT_V(4); PG8_BAR;
    PG8_STAGE(PG8_SB(1, 0), cB + kstep, voffB); PG8_STAGE(PG8_SA(1, 0), cA + kstep, voffA); PG8_STAGE(PG8_SB(1, 1), cB + hstepB + kstep, voffB);
    PG8_WAIT_V(6); PG8_BAR;
    }
    for (;;) {
        const bool has_next = S.next(ui + 1, nxt);
        const char* nA = has_next ? (const char*)g.A + (size_t)nxt.pm * tstepA : cA; const char* nB = has_next ? (const char*)g.Bt + (size_t)nxt.pn * tstepB : cB;
        for (int t = 0; t < nt; t += 2) {
            const bool last = (t == nt - 2);
            const char* a1 = cA + (size_t)(t + 1) * kstep;
            const char* a2 = last ? nA : cA + (size_t)(t + 2) * kstep; const char* b2 = last ? nB : cB + (size_t)(t + 2) * kstep;
            const char* a3 = a2 + kstep; const char* b3 = b2 + kstep;
            if (last && has_next) S.a_ready(nxt);
            if constexpr (SP2) {
            PG8_LDB(B0, 0, 0); PG8_LDB(B1, 0, 1); PG8_SCHED; PG8_LDA(At, 0, 0); PG8_STAGE(PG8_SA(1, 1), a1 + hstepA, voffA);
            PG8_WAIT_V(8); PG8_WAIT_L(0); PG8_BAR; PG8_MMA(0, 0, At, B0); PG8_MMA(0, 1, At, B1); PG8_BAR; PG8_SCHED;
            PG8_LDA(At, 0, 1); PG8_STAGE(PG8_SB(0, 0), b2, voffB); PG8_STAGE(PG8_SB(0, 1), b2 + hstepB, voffB); PG8_STAGE(PG8_SA(0, 0), a2, voffA);
            PG8_WAIT_V(8); PG8_WAIT_L(0); PG8_BAR; PG8_MMA(1, 0, At, B0); PG8_MMA(1, 1, At, B1); PG8_BAR; PG8_SCHED;
            PG8_LDB(B0, 1, 0); PG8_LDB(B1, 1, 1); PG8_SCHED; PG8_LDA(At, 1, 0); PG8_STAGE(PG8_SA(0, 1), a2 + hstepA, voffA);
            PG8_WAIT_V(8); PG8_WAIT_L(0); PG8_BAR; PG8_MMA(0, 0, At, B0); PG8_MMA(0, 1, At, B1); PG8_BAR; PG8_SCHED;
            PG8_LDA(At, 1, 1); PG8_STAGE(PG8_SB(1, 0), b3, voffB); PG8_STAGE(PG8_SB(1, 1), b3 + hstepB, voffB); PG8_STAGE(PG8_SA(1, 0), a3, voffA);
            PG8_WAIT_V(8); PG8_WAIT_L(0); PG8_BAR; PG8_MMA(1, 0, At, B0); PG8_MMA(1, 1, At, B1); PG8_BAR; PG8_SCHED;
            } else {
            PG8_LDB(B0, 0, 0); PG8_SCHED; PG8_LDA(At, 0, 0); PG8_STAGE(PG8_SA(1, 1), a1 + hstepA, voffA);
            PG8_WAIT_L(8); PG8_BAR; PG8_WAIT_L(0); PG8_MMA(0, 0, At, B0); PG8_BAR; PG8_SCHED;
            PG8_LDB(B1, 0, 1); PG8_STAGE(PG8_SB(0, 0), b2, voffB);
            PG8_BAR; PG8_WAIT_L(0); PG8_MMA(0, 1, At, B1); PG8_BAR;
            PG8_LDA(At, 0, 1); PG8_STAGE(PG8_SA(0, 0), a2, voffA);
            PG8_BAR; PG8_WAIT_L(0); PG8_MMA(1, 0, At, B0); PG8_BAR; PG8_SCHED;
            PG8_STAGE(PG8_SB(0, 1), b2 + hstepB, voffB);
            PG8_WAIT_V(6); PG8_BAR; PG8_MMA(1, 1, At, B1); PG8_BAR;
            PG8_LDB(B0, 1, 0); PG8_SCHED; PG8_LDA(At, 1, 0); PG8_STAGE(PG8_SA(0, 1), a2 + hstepA, voffA);
            PG8_WAIT_L(8); PG8_BAR; PG8_WAIT_L(0); PG8_MMA(0, 0, At, B0); PG8_BAR; PG8_SCHED;
            PG8_LDB(B1, 1, 1); PG8_STAGE(PG8_SB(1, 0), b3, voffB);
            PG8_BAR; PG8_WAIT_L(0); PG8_MMA(0, 1, At, B1); PG8_BAR;
            PG8_LDA(At, 1, 1); PG8_STAGE(PG8_SA(1, 0), a3, voffA);
            PG8_BAR; PG8_WAIT_L(0); PG8_MMA(1, 0, At, B0); PG8_BAR; PG8_SCHED;
            PG8_STAGE(PG8_SB(1, 1), b3 + hstepB, voffB);
            PG8_WAIT_V(6); PG8_BAR; PG8_MMA(1, 1, At, B1); PG8_BAR;
            }
        }
        if constexpr (FP8) asm volatile("s_nop 15\n\ts_nop 15" ::: "memory");
        if (wr == 0) PG8_BAR;
        int fr_ = fr, fq_ = fq; asm volatile("" : "+v"(fr_), "+v"(fq_));
        if (PROBE == 0) E(acc, cur, wr, wc, fr_, fq_); else { float sacc = 0.f; _Pragma("unroll") for (int a_ = 0; a_ < 2; ++a_) _Pragma("unroll") for (int b_ = 0; b_ < 2; ++b_) _Pragma("unroll") for (int m_ = 0; m_ < 4; ++m_) _Pragma("unroll") for (int n_ = 0; n_ < 2; ++n_) sacc += acc[a_][b_][m_][n_][0] + acc[a_][b_][m_][n_][1] + acc[a_][b_][m_][n_][2] + acc[a_][b_][m_][n_][3]; if (sacc == 1.2345e-30f) *(float*)g.A = sacc; }
        S.done(cur);
        if (!has_next) break;
#pragma unroll
        for (int a = 0; a < 2; ++a)
#pragma unroll
            for (int b = 0; b < 2; ++b)
#pragma unroll
                for (int m = 0; m < 4; ++m)
#pragma unroll
                    for (int n = 0; n < 2; ++n) acc[a][b][m][n] = (f32x4){0.f, 0.f, 0.f, 0.f};
        cur = nxt; cA = nA; cB = nB; ++ui;
        if (wr == 1) PG8_BAR;
    }
    PG8_WAIT_V(0);
    PG8_BAR;
#undef PG8_SA
#undef PG8_SB
#undef PG8_STAGE
#undef PG8_LDA
#undef PG8_LDB
#undef PG8_MMA
#undef PG8_CAT
#undef PG8_WAIT_V
#undef PG8_WAIT_L
#undef PG8_BAR
#undef PG8_SCHED
}
}

constexpr int NWAVES = 8;
constexpr int M = 16384, SEQ = 8192, DM = 4096;
constexpr int D_SSM = 8192, D_CONV = 10240, NH_SSM = 128, NG = 8, NSTATE = 128, CHUNK = 128;
constexpr int NHEAD = 32, QK_NOPE = 128, QK_ROPE = 64, VH = 128, Q_LORA = 1024, KV_LORA = 512;
constexpr int D_IN = 32448, NP = 32512;
constexpr int PC_Z = 0, PC_XBC = 8192, PC_GSSM = 18432, PC_A0 = 18432, PC_CQ = 22528, PC_GATTN = 23552, PC_GATT2 = 27648, PC_KV = 31744;
constexpr int N16 = 18688, N8 = 14080, GC_DT = 18432;
constexpr int SC_Z = 0, SC_XBC = 8192, SC_DT = 18432, SC_CQ = 18560, SC_KV = 19584, SC_GATTN = 20160, SC_GSSM = 24256, SC_GATT2 = 28352;
constexpr float EPS = 1e-6f;

constexpr size_t MiB = 1u << 20;
constexpr size_t WS_CTL = 0, CTL_ZERO_BYTES = 1 * MiB;
constexpr size_t WS_RSTDQ = 1 * MiB;
constexpr size_t WS_RSTDKV = WS_RSTDQ + 65536;
constexpr size_t WS_COS = 2 * MiB, WS_SIN = 3 * MiB;
constexpr size_t WS_KROPE = 4 * MiB;
constexpr size_t WS_DT32 = 6 * MiB;
constexpr size_t WS_WUQ = 14 * MiB;
constexpr size_t WS_WUKV = 26 * MiB;
constexpr size_t WS_WIN = 34 * MiB;
constexpr size_t WS_QN = WS_WIN, WS_QR = WS_WIN + 128 * MiB, WS_MERGED = WS_WIN;
constexpr size_t WS_WIN8 = WS_WIN + 148 * MiB;
constexpr size_t WS_CQ8 = WS_WIN + 224 * MiB, WS_KV8 = WS_WIN + 240 * MiB;
constexpr size_t WS_QN8 = WS_WIN, WS_QR8 = WS_WIN + 64 * MiB, WS_K8 = WS_WIN + 96 * MiB, WS_VT8 = WS_WIN + 160 * MiB;
constexpr size_t WS_U = 288 * MiB;
constexpr size_t WS_O = WS_U, WS_H16 = WS_U;
constexpr size_t WS_PROJ = 416 * MiB;
constexpr size_t WS_XBC = 1432 * MiB;
constexpr size_t WS_KV = 1752 * MiB;
constexpr size_t WS_U8 = WS_XBC;
constexpr size_t WS_WBS = WS_KV, WS_WBA = WS_KV + 64 * MiB, WS_WOUT = WS_KV + 96 * MiB;
constexpr size_t WS_END = 2008 * MiB;
constexpr size_t WS_ACS = 2011 * MiB;
constexpr size_t WS_KR8 = 2019 * MiB;
constexpr size_t WS_TOTAL = 2020 * MiB;
static_assert(WS_WIN8 + (size_t)N8 * 4096 <= WS_CQ8 && WS_VT8 + (size_t)64 * MiB <= WS_CQ8 && WS_CQ8 + (size_t)M * 1024 <= WS_KV8 && WS_KV8 + (size_t)M * 512 <= WS_U, "ws map 3");
static_assert(WS_WIN + (size_t)N16 * 4096 * 2 <= WS_WIN8 && WS_WIN8 + (size_t)N8 * 4096 <= WS_U && PC_A0 + N8 == NP && PC_KV + 576 <= NP && WS_PROJ + (size_t)M * NP * 2 <= WS_XBC && WS_XBC + (size_t)M * D_CONV * 2 <= WS_KV && WS_KV + (size_t)M * 8192 * 2 <= WS_END, "ws map");
static_assert(WS_WUQ + (size_t)6144 * 1024 * 2 <= WS_WUKV && WS_WUKV + (size_t)8192 * 512 * 2 <= WS_WIN && WS_DT32 + (size_t)M * 128 * 4 <= WS_WUQ, "ws map 2");

constexpr int CW_TMO = 0, CW_CODE = 1;
constexpr int CW_BAR = 4096;
constexpr int CW_CHK = 16384;
constexpr int CW_XSYNC = 20480;

constexpr int RING_OFF = 0, RING_BYTES = 131072;
constexpr int LDSCTL_OFF = RING_BYTES, MISC_OFF = LDSCTL_OFF + 320;
constexpr int SSD_TAB_OFF = RING_BYTES + 1024;
constexpr int LDS_BYTES = 163840;

#define GAS __attribute__((address_space(1)))
#define LAS __attribute__((address_space(3)))
typedef unsigned short bf16;
typedef unsigned v4u __attribute__((ext_vector_type(4)));
typedef unsigned v2u __attribute__((ext_vector_type(2)));
typedef float f32x4 __attribute__((ext_vector_type(4)));
typedef float f32x16 __attribute__((ext_vector_type(16)));
typedef short bf16x8 __attribute__((ext_vector_type(8)));
typedef short s16x4 __attribute__((ext_vector_type(4)));
typedef GAS unsigned gu32;
#define RLX_AGENT __ATOMIC_RELAXED, __HIP_MEMORY_SCOPE_AGENT
#define LDS_WAIT() asm volatile("s_waitcnt lgkmcnt(0)" ::: "memory")
#define VM_WAIT() asm volatile("s_waitcnt vmcnt(0)" ::: "memory")
__device__ __forceinline__ unsigned f2bf(float f) { unsigned u = __builtin_bit_cast(unsigned, f); return (u + 0x7fffu + ((u >> 16) & 1u)) >> 16; }
__device__ __forceinline__ unsigned pk2(float lo, float hi) { return f2bf(lo) | (f2bf(hi) << 16); }
__device__ __forceinline__ float bflo(unsigned w) { return __uint_as_float(w << 16); }
__device__ __forceinline__ float bfhi(unsigned w) { return __uint_as_float(w & 0xffff0000u); }
__device__ __forceinline__ float bf2f(bf16 b) { return __uint_as_float(((unsigned)b) << 16); }
__device__ __forceinline__ float silu_(float x) { return x * __builtin_amdgcn_rcpf(1.0f + __expf(-x)); }
__device__ __forceinline__ unsigned cvtpk(float lo, float hi) { unsigned r; asm volatile("v_cvt_pk_bf16_f32 %0, %1, %2" : "=v"(r) : "v"(lo), "v"(hi)); return r; }
__device__ __forceinline__ int crow(int r, int hi) { return (r & 3) + 8 * (r >> 2) + 4 * hi; }
__device__ __forceinline__ s16x4 tr_read(unsigned addr) { typedef short v4i16_t __attribute__((ext_vector_type(4))); return __builtin_bit_cast(s16x4, __builtin_amdgcn_ds_read_tr16_b64_v4i16((LAS v4i16_t*)(uintptr_t)addr)); }
__device__ __forceinline__ void glds16(const void* gbase  , unsigned voff, unsigned lds_dst) { unsigned keep;
    asm volatile("s_nop 4\n\ts_mov_b32 %0, m0\n\ts_mov_b32 m0, %3\n\ts_nop 0\n\tglobal_load_lds_dwordx4 %1, %2\n\ts_mov_b32 m0, %0" : "=&s"(keep) : "v"(voff), "s"(gbase), "s"(lds_dst) : "memory"); }

#define XB_TMO      128
#define XB_XCNT(j)  (256  + 64 * (j))
#define XB_XSUB(j)  (1280 + 64 * (j))
#define XB_XGEN(j)  (2304 + 64 * (j))
#define XB_TOP      3328
#define XB_TOPGEN   3392
#define XCD_BAR_WORDS 3456
#define XB_SPIN_CAP (1u << 22)
__device__ __forceinline__ unsigned xb_ld(unsigned* p)              { return __hip_atomic_load(p, __ATOMIC_RELAXED, __HIP_MEMORY_SCOPE_AGENT); }
__device__ __forceinline__ unsigned xb_add(unsigned* p, unsigned v) { return __hip_atomic_fetch_add(p, v, __ATOMIC_RELAXED, __HIP_MEMORY_SCOPE_AGENT); }
__device__ __forceinline__ unsigned xb_xcc_id() { return (unsigned)__builtin_amdgcn_s_getreg((3 << 11) | 20) & 0xFu; }
#define XB_SPIN(cond, bar) do { unsigned _sp = 0; while (cond) { __builtin_amdgcn_s_sleep(1); \
    if ((++_sp & 255u) == 0u) { if (xb_ld(&(bar)[XB_TMO])) break; if (_sp > XB_SPIN_CAP) { atomicAdd(&(bar)[XB_TMO], 1u); break; } } } } while (0)
struct XcdBarrier { unsigned* bar; unsigned x; volatile LAS unsigned* st; };
__device__ __forceinline__ XcdBarrier xcd_barrier_post(unsigned* bar, volatile LAS unsigned* st) {
    XcdBarrier b; b.bar = bar; b.x = xb_xcc_id(); b.st = st;
    if (threadIdx.x == 0) (void)xb_add(&bar[XB_XCNT(b.x)], 1u);
    return b;
}
__device__ __forceinline__ void xcd_barrier_complete(unsigned* bar, unsigned x, unsigned& nloc, unsigned& nx) {
    const unsigned G = gridDim.x * gridDim.y * gridDim.z;
    unsigned sum, cnt, mine, sp = 0u;
    for (;;) {
        sum = 0u; cnt = 0u; mine = 0u;
#pragma unroll
        for (unsigned j = 0; j < 16; ++j) { const unsigned c = xb_ld(&bar[XB_XCNT(j)]); sum += c; cnt += (c > 0u) ? 1u : 0u; mine = (j == x) ? c : mine; }
        if (sum == G) break;
        __builtin_amdgcn_s_sleep(1);
        if ((++sp & 255u) == 0u) { if (xb_ld(&bar[XB_TMO])) break; if (sp > XB_SPIN_CAP) { atomicAdd(&bar[XB_TMO], 1u); break; } }
    }
    nloc = mine > 0u ? mine : 1u; nx = cnt > 0u ? cnt : 1u;
}
__device__ __forceinline__ void xcd_barrier(const XcdBarrier& b) {
    asm volatile("s_waitcnt vmcnt(0)" ::: "memory");
    __syncthreads();
    if (threadIdx.x == 0) {
        unsigned* bar = b.bar;
        __builtin_amdgcn_s_waitcnt(0);
        unsigned nloc = b.st[0], nx = b.st[1];
        if (nloc == 0u) { xcd_barrier_complete(bar, b.x, nloc, nx); b.st[0] = nloc; b.st[1] = nx; }
        const unsigned old = xb_add(&bar[XB_XSUB(b.x)], 1u);
        const unsigned gen = old / nloc;
        if (old + 1u == (gen + 1u) * nloc) {
            __builtin_amdgcn_fence(__ATOMIC_RELEASE, "agent");
            asm volatile("s_waitcnt vmcnt(0)" ::: "memory");
            const unsigned og = xb_add(&bar[XB_TOP], 1u);
            const unsigned tg = og / nx;
            if (og + 1u == (tg + 1u) * nx) xb_add(&bar[XB_TOPGEN], 1u);
            else XB_SPIN(xb_ld(&bar[XB_TOPGEN]) == tg, bar);
            __builtin_amdgcn_fence(__ATOMIC_ACQUIRE, "agent");
            xb_add(&bar[XB_XGEN(b.x)], 1u);
            asm volatile("s_waitcnt vmcnt(0)" ::: "memory");
        } else {
            XB_SPIN(xb_ld(&bar[XB_XGEN(b.x)]) == gen, bar);
            __builtin_amdgcn_fence(__ATOMIC_ACQUIRE, "agent");
            asm volatile("s_waitcnt vmcnt(0)" ::: "memory");
        }
    }
    __syncthreads();
}

struct Args {
    const float* x; const float* norm_in_w; const float* w_in; const float* conv_w; const float* conv_b; const float* dt_bias; const float* a_log; const float* d_skip;
    const float* ssm_norm_w; const float* q_norm_w; const float* w_uq; const float* kv_norm_w; const float* w_ukv; const float* w_bs; const float* w_ba; const float* w_out; const float* norm_final_w;
    float* out; unsigned char* ws; int ph_lo, ph_hi;
};
struct Frame {
    LAS unsigned char* lds; volatile LAS unsigned* MISC; gu32* ctl;
    int tid, lane, wave, vcu, G;
};
__device__ __forceinline__ float wave_sum(float v) {
#pragma unroll
    for (int o = 1; o < 64; o <<= 1) v += __shfl_xor(v, o);
    return v;
}

template <class F>
__device__ __forceinline__ void transpose_item(const float* W, int K, int N, bf16* WT, LAS float* scr, int item, int nblk, int lane, const float* kscale, F srccol) {
    const int kb = item / nblk, nb = item % nblk, k0 = 64 * kb, n0 = 32 * nb;
    const int sc = srccol(n0 + (lane & 31));
    float tv[32];
    { const float* wp = W + (size_t)(k0 + (lane >> 5)) * N + (sc >= 0 ? sc : 0);
#pragma unroll
      for (int i = 0; i < 32; ++i) tv[i] = wp[(size_t)(2 * i) * N]; }
#pragma unroll
    for (int i = 0; i < 32; ++i) { const int kk = 2 * i + (lane >> 5); float v = (sc >= 0) ? tv[i] : 0.f; if (kscale) v *= kscale[k0 + kk]; scr[kk * 33 + (lane & 31)] = v; }
    LDS_WAIT(); asm volatile("" ::: "memory");
    const int c = lane & 7;
#pragma unroll
    for (int j = 0; j < 4; ++j) { const int n = (lane >> 3) + 8 * j; const LAS float* s = scr + (8 * c) * 33 + n;
        v4u o; o.x = pk2(s[0 * 33], s[1 * 33]); o.y = pk2(s[2 * 33], s[3 * 33]); o.z = pk2(s[4 * 33], s[5 * 33]); o.w = pk2(s[6 * 33], s[7 * 33]);
        *(GAS v4u*)(WT + (size_t)(n0 + n) * K + k0 + 8 * c) = o; }
    LDS_WAIT(); asm volatile("" ::: "memory");
}
template <class F>
__device__ __forceinline__ void transpose_item8(const float* W, int K, int N, unsigned char* WT, int ldt, LAS float* scr, int item, int nblk, int lane, float oscale, F srccol, const float* kscale = nullptr) {
    const int kb = item / nblk, nb = item % nblk, k0 = 64 * kb, n0 = 32 * nb;
    const int sc = srccol(n0 + (lane & 31));
    float tv[32];
    { const float* wp = W + (size_t)(k0 + (lane >> 5)) * N + (sc >= 0 ? sc : 0);
#pragma unroll
      for (int i = 0; i < 32; ++i) tv[i] = wp[(size_t)(2 * i) * N]; }
#pragma unroll
    for (int i = 0; i < 32; ++i) { const int kk = 2 * i + (lane >> 5); float v = (sc >= 0) ? tv[i] * oscale : 0.f; if (kscale) v *= kscale[k0 + kk]; scr[kk * 33 + (lane & 31)] = v; }
    LDS_WAIT(); asm volatile("" ::: "memory");
    const int c = lane & 7;
#pragma unroll
    for (int j = 0; j < 4; ++j) { const int n = (lane >> 3) + 8 * j; const LAS float* sp = scr + (8 * c) * 33 + n;
        v2u o; o.x = pg8::pk4_fp8(sp[0 * 33], sp[1 * 33], sp[2 * 33], sp[3 * 33]); o.y = pg8::pk4_fp8(sp[4 * 33], sp[5 * 33], sp[6 * 33], sp[7 * 33]);
        *(GAS v2u*)(WT + (size_t)(n0 + n) * ldt + k0 + 8 * c) = o; }
    LDS_WAIT(); asm volatile("" ::: "memory");
}
struct SrcIn16 { __device__ __forceinline__ int operator()(int n) const {
    if (n < GC_DT) return n;
    if (n < GC_DT + 128) return n - GC_DT + SC_DT;
    return -1; } };
struct SrcIn8 { __device__ __forceinline__ int operator()(int n) const {
    n += PC_A0;
    if (n < PC_CQ) return n - PC_GSSM + SC_GSSM;
    if (n < PC_GATTN) return n - PC_CQ + SC_CQ;
    if (n < PC_GATT2) return n - PC_GATTN + SC_GATTN;
    if (n < PC_KV) return n - PC_GATT2 + SC_GATT2;
    if (n < PC_KV + 576) return n - PC_KV + SC_KV;
    return -1; } };
struct SrcUq { __device__ __forceinline__ int operator()(int n) const {
    if (n < 4096) return (n >> 7) * 192 + (n & 127);
    const int r = n - 4096, h = r >> 6, j = r & 63; return h * 192 + 128 + (j & 1) * 32 + (j >> 1); } };
struct SrcId { __device__ __forceinline__ int operator()(int n) const { return n; } };
struct SrcUkv { __device__ __forceinline__ int operator()(int n) const { const int r = n & 4095; return (r >> 7) * 256 + (n >> 12) * 128 + (r & 127); } };

struct TItem { const float* W; unsigned char* WT; const float* ksc; int K, N, ldt, nblk, r, map; float osc; bool f8; };
__device__ __forceinline__ int titem_src(int map, int n) { return map == 0 ? SrcIn16()(n) : map == 1 ? SrcIn8()(n) : map == 2 ? SrcUq()(n) : map == 3 ? SrcUkv()(n) : n; }
__device__ __forceinline__ bool titem_vec(const TItem& t) { return t.map != 2 || 32 * (t.r % t.nblk) < 4096; }
__device__ __forceinline__ void titem_load(const TItem& t, int lane, float (&tv)[32], int& sc) {
    const int kb = t.r / t.nblk, nb = t.r % t.nblk, k0 = 64 * kb, n0 = 32 * nb;
    if (titem_vec(t)) {
        sc = titem_src(t.map, n0);
        const float* wp = t.W + (size_t)(k0 + (lane >> 3)) * t.N + (sc >= 0 ? sc : 0) + 4 * (lane & 7);
#pragma unroll
        for (int i = 0; i < 8; ++i) { const f32x4 v = *(const GAS f32x4*)(wp + (size_t)(8 * i) * t.N); tv[4 * i] = v.x; tv[4 * i + 1] = v.y; tv[4 * i + 2] = v.z; tv[4 * i + 3] = v.w; }
        return;
    }
    sc = titem_src(t.map, n0 + (lane & 31));
    const float* wp = t.W + (size_t)(k0 + (lane >> 5)) * t.N + (sc >= 0 ? sc : 0);
#pragma unroll
    for (int i = 0; i < 32; ++i) tv[i] = wp[(size_t)(2 * i) * t.N];
}
__device__ __forceinline__ void titem_finish(const TItem& t, int lane, const float (&tv)[32], int sc, LAS float* scr) {
    const int kb = t.r / t.nblk, nb = t.r % t.nblk, k0 = 64 * kb, n0 = 32 * nb;
    if (titem_vec(t)) {
#pragma unroll
        for (int i = 0; i < 32; ++i) { const int kk = (lane >> 3) + 8 * (i >> 2), nn = 4 * (lane & 7) + (i & 3); float v = (sc >= 0) ? tv[i] * t.osc : 0.f; if (t.ksc) v *= t.ksc[k0 + kk]; scr[kk * 33 + nn] = v; }
    } else {
#pragma unroll
        for (int i = 0; i < 32; ++i) { const int kk = 2 * i + (lane >> 5); float v = (sc >= 0) ? tv[i] * t.osc : 0.f; if (t.ksc) v *= t.ksc[k0 + kk]; scr[kk * 33 + (lane & 31)] = v; }
    }
    LDS_WAIT(); asm volatile("" ::: "memory");
    const int c = lane & 7;
    if (t.f8) {
#pragma unroll
        for (int j = 0; j < 4; ++j) { const int n = (lane >> 3) + 8 * j; const LAS float* sp = scr + (8 * c) * 33 + n;
            v2u o; o.x = pg8::pk4_fp8(sp[0 * 33], sp[1 * 33], sp[2 * 33], sp[3 * 33]); o.y = pg8::pk4_fp8(sp[4 * 33], sp[5 * 33], sp[6 * 33], sp[7 * 33]);
            *(GAS v2u*)(t.WT + (size_t)(n0 + n) * t.ldt + k0 + 8 * c) = o; }
    } else {
#pragma unroll
        for (int j = 0; j < 4; ++j) { const int n = (lane >> 3) + 8 * j; const LAS float* sp = scr + (8 * c) * 33 + n;
            v4u o; o.x = pk2(sp[0 * 33], sp[1 * 33]); o.y = pk2(sp[2 * 33], sp[3 * 33]); o.z = pk2(sp[4 * 33], sp[5 * 33]); o.w = pk2(sp[6 * 33], sp[7 * 33]);
            *(GAS v4u*)(t.WT + (size_t)(n0 + n) * t.ldt + (size_t)(k0 + 8 * c) * 2) = o; }
    }
    LDS_WAIT(); asm volatile("" ::: "memory");
}
template <class Dec> __device__ __forceinline__ void transpose_stream(const Dec& dec, int total, int gw, int NGW, int lane, LAS float* scr) {
    int it = gw; if (it >= total) return;
    TItem cur = dec(it); float tva[32]; int sca; titem_load(cur, lane, tva, sca);
    for (;;) {
        const int itn = it + NGW; const bool hn = itn < total;
        TItem nxt = cur; float tvb[32]; int scb = -1;
        if (hn) { nxt = dec(itn); titem_load(nxt, lane, tvb, scb); }
        titem_finish(cur, lane, tva, sca, scr);
        if (!hn) break;
        cur = nxt; sca = scb; it = itn;
#pragma unroll
        for (int i = 0; i < 32; ++i) tva[i] = tvb[i];
    }
}

__device__ __forceinline__ void p0_prologue(Frame& F, const Args& a) {
    LAS float* scr = (LAS float*)(F.lds + RING_OFF + F.wave * 16384);
    const int gw = F.vcu * NWAVES + F.wave, NGW = F.G * NWAVES;
    unsigned char* ws = a.ws;
    f32x4 wn[16];
    { const GAS f32x4* wr = (const GAS f32x4*)a.norm_in_w + F.lane;
#pragma unroll
      for (int j = 0; j < 16; ++j) wn[j] = wr[64 * j]; }
    for (int m = gw; m < M; m += NGW) {
        const GAS f32x4* xr = (const GAS f32x4*)(a.x + (size_t)m * DM) + F.lane;
        f32x4 v[16]; float s = 0.f;
#pragma unroll
        for (int j = 0; j < 16; ++j) { v[j] = xr[64 * j]; s += (v[j].x * v[j].x + v[j].y * v[j].y) + (v[j].z * v[j].z + v[j].w * v[j].w); }
        const float rstd = 1.0f / sqrtf(wave_sum(s) * (1.f / DM) + EPS);
        GAS v2u* o8 = (GAS v2u*)((bf16*)(ws + WS_U) + (size_t)m * DM) + F.lane;
        GAS unsigned* u8 = (GAS unsigned*)(ws + WS_U8 + (size_t)m * DM) + F.lane;
#pragma unroll
        for (int j = 0; j < 16; ++j) { const f32x4 w = wn[j]; const float u0 = v[j].x * rstd * w.x, u1 = v[j].y * rstd * w.y, u2 = v[j].z * rstd * w.z, u3 = v[j].w * rstd * w.w;
            v2u o; o.x = pk2(u0, u1); o.y = pk2(u2, u3); o8[64 * j] = o; u8[64 * j] = pg8::pk4_fp8(u0, u1, u2, u3); }
    }
    for (int idx = (F.vcu * 512 + F.tid); idx < SEQ * 32; idx += F.G * 512) {
        const int t = idx >> 5, i = idx & 31;
        double f = 1.0; for (int k = 0; k < i; ++k) f *= 0.74989420933245582730;
        const double av = (double)t * f * 0.15915494309189533577;
        const float fr = (float)(av - __builtin_rint(av));
        ((float*)(ws + WS_COS))[idx] = __builtin_amdgcn_cosf(fr); ((float*)(ws + WS_SIN))[idx] = __builtin_amdgcn_sinf(fr);
    }
    constexpr int I_IN = (DM / 64) * (N16 / 32), I_IN8 = (DM / 64) * (N8 / 32), I_UQ = (Q_LORA / 64) * (6144 / 32), I_UKV = (KV_LORA / 64) * (8192 / 32);
    auto dec = [&](int it) -> TItem {
        int r = it;
        if (r < I_IN) return TItem{a.w_in, ws + WS_WIN, nullptr, DM, D_IN, DM * 2, N16 / 32, r, 0, 1.0f, false}; r -= I_IN;
        if (r < I_IN8) return TItem{a.w_in, ws + WS_WIN8, nullptr, DM, D_IN, DM, N8 / 32, r, 1, 64.0f, true}; r -= I_IN8;
        if (r < I_UQ) return TItem{a.w_uq, ws + WS_WUQ, a.q_norm_w, Q_LORA, 6144, Q_LORA, 6144 / 32, r, 2, 32.0f, true}; r -= I_UQ;
        return TItem{a.w_ukv, ws + WS_WUKV, a.kv_norm_w, KV_LORA, 8192, KV_LORA, 8192 / 32, r, 3, 32.0f, true}; };
    transpose_stream(dec, I_IN + I_IN8 + I_UQ + I_UKV, gw, NGW, F.lane, scr);
}

#ifndef CONV_RG
#define CONV_RG 32
#endif
__device__ __forceinline__ void p2_thin(Frame& F, const Args& a) {
    unsigned char* ws = a.ws;
    const bf16* PROJ = (const bf16*)(ws + WS_PROJ); bf16* XBC = (bf16*)(ws + WS_XBC);
    const int gw = F.vcu * NWAVES + F.wave, NGW = F.G * NWAVES;
    for (int it = gw; it < (M / 32) * 20; it += NGW) {
        const int rb = it / 20, sg = it % 20, c0 = sg * 512 + F.lane * 8, m0 = rb * 32, t0 = m0 & (SEQ - 1);
        float w[4][8], bb[8];
#pragma unroll
        for (int k = 0; k < 4; ++k) { const f32x4 w0 = *(const GAS f32x4*)(a.conv_w + k * D_CONV + c0), w1 = *(const GAS f32x4*)(a.conv_w + k * D_CONV + c0 + 4);
            w[k][0] = w0.x; w[k][1] = w0.y; w[k][2] = w0.z; w[k][3] = w0.w; w[k][4] = w1.x; w[k][5] = w1.y; w[k][6] = w1.z; w[k][7] = w1.w; }
        { const f32x4 b0 = *(const GAS f32x4*)(a.conv_b + c0), b1 = *(const GAS f32x4*)(a.conv_b + c0 + 4); bb[0] = b0.x; bb[1] = b0.y; bb[2] = b0.z; bb[3] = b0.w; bb[4] = b1.x; bb[5] = b1.y; bb[6] = b1.z; bb[7] = b1.w; }
        const bf16* src = PROJ + (size_t)m0 * NP + PC_XBC + c0;
        v4u r0 = {0, 0, 0, 0}, r1 = r0, r2 = r0;
        if (t0 != 0) { r0 = *(const GAS v4u*)(src - 3 * (size_t)NP); r1 = *(const GAS v4u*)(src - 2 * (size_t)NP); r2 = *(const GAS v4u*)(src - (size_t)NP); }
        for (int rg = 0; rg < 32; rg += CONV_RG) {
            v4u rr[CONV_RG];
#pragma unroll
            for (int r8 = 0; r8 < CONV_RG; ++r8) rr[r8] = *(const GAS v4u*)(src + (size_t)(rg + r8) * NP);
#pragma unroll
        for (int r8 = 0; r8 < CONV_RG; ++r8) { const int r = rg + r8;
            const v4u r3 = rr[r8];
            float o[8];
#pragma unroll
            for (int j = 0; j < 4; ++j) {
                o[2 * j]     = bb[2 * j]     + w[0][2 * j]     * bflo(r0[j]) + w[1][2 * j]     * bflo(r1[j]) + w[2][2 * j]     * bflo(r2[j]) + w[3][2 * j]     * bflo(r3[j]);
                o[2 * j + 1] = bb[2 * j + 1] + w[0][2 * j + 1] * bfhi(r0[j]) + w[1][2 * j + 1] * bfhi(r1[j]) + w[2][2 * j + 1] * bfhi(r2[j]) + w[3][2 * j + 1] * bfhi(r3[j]);
            }
            v4u ov; ov.x = pk2(silu_(o[0]), silu_(o[1])); ov.y = pk2(silu_(o[2]), silu_(o[3])); ov.z = pk2(silu_(o[4]), silu_(o[5])); ov.w = pk2(silu_(o[6]), silu_(o[7]));
            *(GAS v4u*)(XBC + (size_t)(m0 + r) * D_CONV + c0) = ov;
            r0 = r1; r1 = r2; r2 = r3;
        } }
    }
    for (int it = gw; it < 256; it += NGW) {
        const int hh = (it & 1) * 64 + F.lane; const size_t m0 = (size_t)(it >> 1) * CHUNK;
        float* dtp = (float*)(ws + WS_DT32) + m0 * 128 + hh; float* acp = (float*)(ws + WS_ACS) + m0 * 128 + hh;
        const float Ah = -__expf(a.a_log[hh]), dtb = a.dt_bias[hh]; float acc = 0.f;
        for (int r0 = 0; r0 < CHUNK; r0 += 16) { float raw[16];
#pragma unroll
            for (int r = 0; r < 16; ++r) raw[r] = dtp[(size_t)(r0 + r) * 128];
#pragma unroll
            for (int r = 0; r < 16; ++r) { const float x = raw[r] + dtb; float dt; if (x > 20.f) dt = x; else { const float y = __expf(x); dt = y < 0.01f ? y * (1.0f - y * (0.5f - 0.33333333f * y)) : __logf(1.0f + y); }
                acc += dt * Ah; dtp[(size_t)(r0 + r) * 128] = dt; acp[(size_t)(r0 + r) * 128] = acc; } }
    }
    for (int mb = gw; mb < M; mb += 4 * NGW) {
        v4u q0[4], q1[4], k0[4]; float x1[4], x2[4], cc[4], ss[4];
#pragma unroll
        for (int u = 0; u < 4; ++u) { const int m = (mb + u * NGW < M) ? mb + u * NGW : mb; const bf16* pr = PROJ + (size_t)m * NP;
            q0[u] = *(const GAS v4u*)(pr + PC_CQ + F.lane * 16); q1[u] = *(const GAS v4u*)(pr + PC_CQ + F.lane * 16 + 8); k0[u] = *(const GAS v4u*)(pr + PC_KV + F.lane * 8);
            const int t = m & (SEQ - 1), i = F.lane & 31; x1[u] = bf2f(pr[PC_KV + 512 + i]); x2[u] = bf2f(pr[PC_KV + 544 + i]); cc[u] = ((const float*)(ws + WS_COS))[t * 32 + i]; ss[u] = ((const float*)(ws + WS_SIN))[t * 32 + i]; }
#pragma unroll
        for (int u = 0; u < 4; ++u) { const int m = mb + u * NGW; if (m >= M) break;
            float sq = 0.f, sk = 0.f;
#pragma unroll
            for (int j = 0; j < 4; ++j) { float a0 = bflo(q0[u][j]), a1 = bfhi(q0[u][j]), a2 = bflo(q1[u][j]), a3 = bfhi(q1[u][j]); sq += a0 * a0 + a1 * a1 + a2 * a2 + a3 * a3; float y0 = bflo(k0[u][j]), y1 = bfhi(k0[u][j]); sk += y0 * y0 + y1 * y1; }
            sq = wave_sum(sq); sk = wave_sum(sk);
            if (F.lane == 0) { ((float*)(ws + WS_RSTDQ))[m] = 1.0f / sqrtf(sq * (1.f / Q_LORA) + EPS); ((float*)(ws + WS_RSTDKV))[m] = 1.0f / sqrtf(sk * (1.f / KV_LORA) + EPS); }
            if (F.lane < 32) { const float re = x1[u] * cc[u] - x2[u] * ss[u], im = x2[u] * cc[u] + x1[u] * ss[u];
                ((unsigned*)(ws + WS_KROPE))[(size_t)m * 32 + F.lane] = pk2(re, im);
                ((unsigned short*)(ws + WS_KR8))[(size_t)m * 32 + F.lane] = (unsigned short)__builtin_amdgcn_cvt_pk_fp8_f32(re, im, 0, false); } }
    }
}

__host__ __device__ __forceinline__ unsigned off_a(unsigned row, unsigned ch) { return 2048u * (row >> 3) + 512u * (ch >> 2) + 64u * (row & 7) + 16u * ((ch & 3) ^ ((row >> 2) & 3)); }
struct ImgA { unsigned rb0, rb1, tb0, tb1; };
__device__ __forceinline__ ImgA imga_bases(int lane) { const unsigned r32 = lane & 31, hi = lane >> 5, qq = (lane & 15) >> 2, pp = lane & 3, blk = (lane >> 4) & 1; ImgA g;
    g.rb0 = off_a(r32, hi); g.rb1 = off_a(r32, 2 + hi);
    g.tb0 = 2048u * hi + 64u * qq + 16u * ((2 * blk + (pp >> 1)) ^ (2 * hi)) + 8u * (pp & 1);
    g.tb1 = 2048u * hi + 64u * (4 + qq) + 16u * ((2 * blk + (pp >> 1)) ^ (2 * hi + 1)) + 8u * (pp & 1); return g; }
#define MFMA32(A, B, C) __builtin_amdgcn_mfma_f32_32x32x16_bf16(A, B, C, 0, 0, 0)
#define PK4(P, B_, OUT) do { unsigned a0 = cvtpk(P[B_+0], P[B_+1]), a1 = cvtpk(P[B_+2], P[B_+3]); unsigned b0 = cvtpk(P[B_+4], P[B_+5]), b1 = cvtpk(P[B_+6], P[B_+7]); \
        auto r0 = __builtin_amdgcn_permlane32_swap(a0, b0, false, false); auto r1 = __builtin_amdgcn_permlane32_swap(a1, b1, false, false); \
        v4u w_ = {r0[0], r1[0], r0[1], r1[1]}; OUT = __builtin_bit_cast(bf16x8, w_); } while (0)
__device__ __forceinline__ bf16x8 mk8(s16x4 lo, s16x4 hi) { return (bf16x8){lo[0], lo[1], lo[2], lo[3], hi[0], hi[1], hi[2], hi[3]}; }
#define RD128(addr) (*(const LAS bf16x8*)(uintptr_t)(addr))
#define SBAR() __builtin_amdgcn_sched_barrier(0)

namespace ssd {
constexpr int BT_OFF = 0, CT_OFF = 32768, XT_OFF = 65536, XS_OFF = 98304, HB_OFF = 114688;
constexpr int T_ACS = SSD_TAB_OFF, T_EA = SSD_TAB_OFF + 512, T_DT = SSD_TAB_OFF + 1024, T_CD = SSD_TAB_OFF + 1536, SP_OFF = SSD_TAB_OFF + 2048;
static_assert(SP_OFF + 10 * 2048 <= LDS_BYTES && HB_OFF + 16384 <= RING_BYTES, "SSD LDS map");

template <int MODE = 0> __device__ __forceinline__ void ssd_phase(Frame& F, const Args& a, bool dry = false) {
    unsigned char* ws = a.ws; bf16* XBC = (bf16*)(ws + WS_XBC); const float* DTV = (const float*)(ws + WS_DT32); const float* ACS = (const float*)(ws + WS_ACS);
    const int tid = F.tid, lane = F.lane, wid = F.wave, r32 = lane & 31, hi = lane >> 5;
    const unsigned lds0 = (unsigned)(uintptr_t)F.lds; LAS unsigned char* L = F.lds;
    const int li = wid >> 1, pb = wid & 1;
    const int qq = (lane & 15) >> 2, pp = lane & 3, blk = (lane >> 4) & 1;
    ImgA ia = imga_bases(lane);
    unsigned xtb = (8 * hi + qq) * 64 + blk * 32 + pp * 8;
    const int ti0 = (wid == 0) ? 0 : (wid == 1) ? 1 : (wid == 2) ? 1 : (wid <= 5) ? 2 : 3, tj0 = (wid == 0) ? 0 : (wid == 1) ? 0 : (wid == 2) ? 1 : (wid == 3) ? 0 : (wid == 4) ? 1 : (wid == 5) ? 2 : (wid == 6) ? 2 : 3;
    const int ntile = (MODE == 2) ? 0 : (wid < 2) ? 2 : 1, ti1 = 3, tj1 = wid;
    for (int item = F.vcu; item < 256; item += F.G) {
        const int b = item >> 7, hh = item & 127, g = hh >> 4;
        const float Dh = a.d_skip[hh];
        f32x16 hacc = {};
        for (int i = tid; i < 16384 / 16; i += 512) *(LAS v4u*)(L + HB_OFF + i * 16) = (v4u){0, 0, 0, 0};
        v4u pB[4], pC[4]; v4u pXa[2], pXb[2]; float paca[2], pdta[2], pala, pacb[2], pdtb[2], palb;
#define SSD_LOADBC(T) do { const size_t m0_ = (size_t)b * SEQ + (size_t)(T) * CHUNK; \
            _Pragma("unroll") for (int j = 0; j < 4; ++j) { const int q_ = tidv + 512 * j, row_ = q_ >> 4, ch_ = q_ & 15; const bf16* p_ = XBC + (m0_ + row_) * D_CONV + D_SSM + g * 128 + ch_ * 8; pB[j] = *(const GAS v4u*)p_; pC[j] = *(const GAS v4u*)(p_ + 1024); } } while (0)
#define SSD_LOADX(T, pX, pac, pdt, pal) do { const size_t m0_ = (size_t)b * SEQ + (size_t)(T) * CHUNK; \
            _Pragma("unroll") for (int j = 0; j < 2; ++j) { const int q_ = tidv + 512 * j, row_ = q_ >> 3, ch_ = q_ & 7; pX[j] = *(const GAS v4u*)(XBC + (m0_ + row_) * D_CONV + hh * 64 + ch_ * 8); \
                pac[j] = ACS[(m0_ + row_) * 128 + hh]; pdt[j] = DTV[(m0_ + row_) * 128 + hh]; } \
            pal = ACS[(m0_ + 127) * 128 + hh]; } while (0)
#define SSD_WRITE(XB, pX, pac, pdt, pal) do { \
            _Pragma("unroll") for (int j = 0; j < 4; ++j) { const int q_ = tidv + 512 * j, row_ = q_ >> 4, ch_ = q_ & 15; *(LAS v4u*)(L + BT_OFF + off_a(row_, ch_)) = pB[j]; *(LAS v4u*)(L + CT_OFF + off_a(row_, ch_)) = pC[j]; } \
            _Pragma("unroll") for (int j = 0; j < 2; ++j) { const int q_ = tidv + 512 * j, row_ = q_ >> 3, ch_ = q_ & 7; const unsigned ad_ = (ch_ >> 2) * 8192 + row_ * 64 + (ch_ & 3) * 16; \
                const float wv_ = pdt[j] * __expf(pal - pac[j]); const v4u x_ = pX[j]; *(LAS v4u*)(L + XT_OFF + (XB) * 16384 + ad_) = x_; \
                v4u xs_; xs_.x = pk2(bflo(x_.x) * wv_, bfhi(x_.x) * wv_); xs_.y = pk2(bflo(x_.y) * wv_, bfhi(x_.y) * wv_); xs_.z = pk2(bflo(x_.z) * wv_, bfhi(x_.z) * wv_); xs_.w = pk2(bflo(x_.w) * wv_, bfhi(x_.w) * wv_); \
                *(LAS v4u*)(L + XS_OFF + ad_) = xs_; \
                if (ch_ == 0) { ((LAS float*)(L + T_ACS))[row_] = pac[j]; ((LAS float*)(L + T_EA))[row_] = __expf(pac[j]); ((LAS float*)(L + T_DT))[row_] = pdt[j]; } } \
            if (tidv == 0) *(LAS float*)(L + T_CD) = __expf(pal); } while (0)
        int tidv = tid; asm volatile("" : "+v"(tidv));
        SSD_LOADBC(0); SSD_LOADX(0, pXa, paca, pdta, pala); SSD_WRITE(0, pXa, paca, pdta, pala);
        SSD_LOADX(1, pXb, pacb, pdtb, palb);
        LDS_WAIT(); __syncthreads();
#define SSD_ITER(T, XNX, XNac, XNdt, XNal, XFX, XFac, XFdt, XFal) do { \
            asm volatile("" : "+v"(ia.rb0), "+v"(ia.rb1), "+v"(ia.tb0), "+v"(ia.tb1), "+v"(xtb), "+v"(tidv)); \
            if (MODE != 3 && (T) + 1 < SEQ / CHUNK) SSD_LOADBC((T) + 1); \
              \
            const unsigned cbase0 = lds0 + CT_OFF + 8192 * li + ia.rb0, cbase1 = lds0 + CT_OFF + 8192 * li + ia.rb1; \
            f32x16 yacc = {}; \
            if (MODE != 4) { const unsigned hb0 = lds0 + HB_OFF + 8192 * pb + ia.rb0, hb1 = lds0 + HB_OFF + 8192 * pb + ia.rb1; \
              bf16x8 cf[2], hf[2]; cf[0] = RD128(cbase0); hf[0] = RD128(hb0); \
              _Pragma("unroll") for (int ks = 0; ks < 8; ++ks) { if (ks < 7) { cf[(ks + 1) & 1] = RD128((((ks + 1) & 1) ? cbase1 : cbase0) + 512 * ((ks + 1) >> 1)); hf[(ks + 1) & 1] = RD128((((ks + 1) & 1) ? hb1 : hb0) + 512 * ((ks + 1) >> 1)); } \
                  yacc = MFMA32(cf[ks & 1], hf[ks & 1], yacc); } } \
            _Pragma("unroll") for (int r = 0; r < 16; ++r) yacc[r] *= ((const LAS float*)(L + T_EA))[32 * li + crow(r, hi)]; \
            SBAR(); \
            if (MODE != 4) { const float cd = *(const LAS float*)(L + T_CD); \
              _Pragma("unroll") for (int r = 0; r < 16; ++r) hacc[r] *= cd; \
              const unsigned ax = lds0 + XS_OFF + pb * 8192 + xtb, bt0 = lds0 + BT_OFF + ia.tb0 + 512 * li, bt1 = lds0 + BT_OFF + ia.tb1 + 512 * li; \
              bf16x8 af[2], bq[2]; af[0] = mk8(tr_read(ax), tr_read(ax + 256)); bq[0] = mk8(tr_read(bt0), tr_read(bt1)); \
              _Pragma("unroll") for (int ks = 0; ks < 8; ++ks) { if (ks < 7) { af[(ks + 1) & 1] = mk8(tr_read(ax + 1024 * (ks + 1)), tr_read(ax + 1024 * (ks + 1) + 256)); bq[(ks + 1) & 1] = mk8(tr_read(bt0 + 4096 * (ks + 1)), tr_read(bt1 + 4096 * (ks + 1))); } \
                  hacc = MFMA32(af[ks & 1], bq[ks & 1], hacc); } } \
            SBAR(); \
            _Pragma("nounroll") for (int tt = 0; tt < ntile; ++tt) { \
                const int ti = tt ? ti1 : ti0, tj = tt ? tj1 : tj0; \
                f32x16 cbt = {}; \
                { const unsigned bb0 = lds0 + BT_OFF + 8192 * tj + ia.rb0, bb1 = lds0 + BT_OFF + 8192 * tj + ia.rb1, cc0 = lds0 + CT_OFF + 8192 * ti + ia.rb0, cc1 = lds0 + CT_OFF + 8192 * ti + ia.rb1; \
                  bf16x8 bf_[2], cf[2]; bf_[0] = RD128(bb0); cf[0] = RD128(cc0); \
                  _Pragma("unroll") for (int ks = 0; ks < 8; ++ks) { if (ks < 7) { bf_[(ks + 1) & 1] = RD128((((ks + 1) & 1) ? bb1 : bb0) + 512 * ((ks + 1) >> 1)); cf[(ks + 1) & 1] = RD128((((ks + 1) & 1) ? cc1 : cc0) + 512 * ((ks + 1) >> 1)); } \
                      cbt = MFMA32(bf_[ks & 1], cf[ks & 1], cbt); } } \
                const float acs_l = ((const LAS float*)(L + T_ACS))[32 * ti + r32]; \
                const bool diag = (ti == tj); \
                _Pragma("unroll") for (int r4 = 0; r4 < 4; ++r4) { const int s0_ = 32 * tj + 8 * r4 + 4 * hi; \
                    const f32x4 as4 = *(const LAS f32x4*)(L + T_ACS + 4 * s0_), ds4 = *(const LAS f32x4*)(L + T_DT + 4 * s0_); \
                    _Pragma("unroll") for (int e = 0; e < 4; ++e) { const int r = 4 * r4 + e, sl = 8 * r4 + 4 * hi + e; \
                        float v = cbt[r] * __expf(fminf(acs_l - as4[e], 0.f)) * ds4[e]; \
                        if (diag) { v = (sl > r32) ? 0.f : v; v += (sl == r32) ? Dh : 0.f; } \
                        cbt[r] = v; } } \
                bf16x8 pa0, pa1; \
                PK4(cbt, 0, pa0); PK4(cbt, 8, pa1); \
                const unsigned sp = lds0 + SP_OFF + (ti * (ti + 1) / 2 + tj) * 2048 + lane * 16; \
                *(LAS bf16x8*)(uintptr_t)sp = pa0; *(LAS bf16x8*)(uintptr_t)(sp + 1024) = pa1; \
            } \
            LDS_WAIT(); __syncthreads(); \
              \
            { const unsigned xa = lds0 + XT_OFF + ((T) & 1) * 16384 + pb * 8192 + xtb, sp = lds0 + SP_OFF + (li * (li + 1) / 2) * 2048 + lane * 16; \
              _Pragma("nounroll") for (int j = 0; j <= li; ++j) { \
                  const bf16x8 pa0 = RD128(sp + j * 2048), pa1 = RD128(sp + j * 2048 + 1024); \
                  const bf16x8 x0 = mk8(tr_read(xa + (32 * j) * 64), tr_read(xa + (32 * j) * 64 + 256)), x1 = mk8(tr_read(xa + (32 * j + 16) * 64), tr_read(xa + (32 * j + 16) * 64 + 256)); \
                  yacc = MFMA32(pa0, x0, yacc); yacc = MFMA32(pa1, x1, yacc); } } \
            if (!dry) { bf16* yp = XBC + ((size_t)b * SEQ + (size_t)(T) * CHUNK + 32 * li) * D_CONV + hh * 64 + 32 * pb + r32; \
              _Pragma("unroll") for (int r = 0; r < 16; ++r) yp[(size_t)crow(r, hi) * D_CONV] = (bf16)f2bf(yacc[r]); } \
            _Pragma("unroll") for (int r = 0; r < 16; ++r) { const int p = 32 * pb + crow(r, hi), n = 32 * li + r32; *(LAS bf16*)(L + HB_OFF + off_a(p, n >> 3) + (n & 7) * 2) = (bf16)f2bf(hacc[r]); } \
            asm volatile("" : "+v"(tidv)); \
            if (MODE != 3 && (T) + 1 < SEQ / CHUNK) { SSD_WRITE(((T) + 1) & 1, XNX, XNac, XNdt, XNal); if ((T) + 2 < SEQ / CHUNK) SSD_LOADX((T) + 2, XFX, XFac, XFdt, XFal); } \
            LDS_WAIT(); __syncthreads(); } while (0)
        for (int T = 0; T < SEQ / CHUNK; T += 2) {
            SSD_ITER(T, pXb, pacb, pdtb, palb, pXa, paca, pdta, pala);
            SSD_ITER(T + 1, pXa, paca, pdta, pala, pXb, pacb, pdtb, palb);
        }
#undef SSD_ITER
#undef SSD_LOADBC
#undef SSD_LOADX
#undef SSD_WRITE
    }
}
}

namespace att {
constexpr int KN_OFF = 0, KR_OFF = 32768, VT_OFF = 49152, QR_OFF = 98304, WS_OFF = SSD_TAB_OFF;
static_assert(QR_OFF + 8 * 4096 <= RING_BYTES && WS_OFF + 8 * 256 <= LDS_BYTES && WS_OFF >= MISC_OFF + 128, "attention LDS map");
constexpr int _unused_att = 0;
constexpr float SCALE = 0.07216878364870322f, C2 = SCALE * 1.4426950408889634f, THR = 8.f;
__device__ __forceinline__ void inv_a(int P, int& row, int& ch) { row = 8 * (P >> 7) + ((P >> 2) & 7); ch = 4 * ((P >> 5) & 3) + ((P & 3) ^ ((row >> 2) & 3)); }

template <int MODE = 0>
__device__ __forceinline__ void attn_phase(Frame& F, const Args& a) {
    unsigned char* ws = a.ws;
    const bf16* QN = (const bf16*)(ws + WS_QN); const bf16* QR = (const bf16*)(ws + WS_QR); const bf16* KV = (const bf16*)(ws + WS_KV); const bf16* KRP = (const bf16*)(ws + WS_KROPE);
    const bf16* PROJ = (const bf16*)(ws + WS_PROJ); bf16* O = (bf16*)(ws + WS_O);
    const int wid = F.wave;
    const bool late = wid >= 4;
    const unsigned lds0 = (unsigned)(uintptr_t)F.lds; LAS unsigned char* L = F.lds;
    LAS float* wsf = (LAS float*)(L + WS_OFF) + wid * 64;
#define WAITBAR() asm volatile("s_waitcnt vmcnt(0) lgkmcnt(0)\n\ts_barrier" ::: "memory")
    for (int v = F.vcu; v < 256; v += F.G) {
        const int bh = v >> 2, s4 = v & 3, b = bh >> 5, h = bh & 31; const size_t rowbase = (size_t)b * SEQ;
        for (int ui = 0; ui < 8; ++ui) {
            int lane = F.lane; asm volatile("" : "+v"(lane));
            const int r32 = lane & 31, hi = lane >> 5;
            ImgA ia = imga_bases(lane);
            unsigned koff[2], roff;
#pragma unroll
            for (int j = 0; j < 2; ++j) { int row, ch; inv_a((2 * wid + j) * 64 + lane, row, ch); koff[j] = (unsigned)(((rowbase + row) * 8192 + h * 256 + ch * 8) * 2); }
            { int R, ch; inv_a(wid * 64 + lane, R, ch); const int key = R + 32 * (ch >> 3), c = ch & 7; roff = (unsigned)(((rowbase + key) * 64 + c * 8) * 2); }
            const int qb = (ui & 1) ? (31 - (s4 + 4 * (ui >> 1))) : (s4 + 4 * (ui >> 1));
            const int q0 = qb * 256, NT = 4 * qb + 4, qrow = q0 + 32 * wid + r32;
            bf16x8 qn[8];
            const unsigned qrl = lds0 + QR_OFF + wid * 4096 + lane * 16;
            { const bf16* qp = QN + (rowbase + qrow) * 4096 + h * 128 + hi * 8;
#pragma unroll
              for (int d0 = 0; d0 < 8; ++d0) qn[d0] = *(const GAS bf16x8*)(qp + d0 * 16);
              const bf16* rp = QR + (rowbase + qrow) * 2048 + h * 64 + hi * 8;
#pragma unroll
              for (int d0 = 0; d0 < 4; ++d0) { const bf16x8 q_ = *(const GAS bf16x8*)(rp + d0 * 16); *(LAS bf16x8*)(uintptr_t)(qrl + d0 * 1024) = q_; }
#pragma unroll
              for (int d0 = 0; d0 < 8; ++d0) asm volatile("" : "+v"(qn[d0])); }
#define ATT_DMA(t) do { if (MODE == 1) break; const unsigned ks_ = ((t) & 1), vs_ = (unsigned)(t) % 3u; \
                _Pragma("unroll") for (int j = 0; j < 2; ++j) { glds16(KV, koff[j] + (unsigned)(t) * (64u * 8192u * 2u), (unsigned)__builtin_amdgcn_readfirstlane(lds0 + KN_OFF + ks_ * 16384 + (2 * wid + j) * 1024)); \
                glds16(KV + 128, koff[j] + (unsigned)(t) * (64u * 8192u * 2u), (unsigned)__builtin_amdgcn_readfirstlane(lds0 + VT_OFF + vs_ * 16384 + (2 * wid + j) * 1024)); } \
                glds16(KRP, roff + (unsigned)(t) * (64u * 64u * 2u), (unsigned)__builtin_amdgcn_readfirstlane(lds0 + KR_OFF + ks_ * 8192 + wid * 1024)); } while (0)
            float m_reg = -1e30f, l_reg = 0.f; f32x16 o[4] = {};
            ATT_DMA(0);
            if (late) { WAITBAR(); if (1 < NT) ATT_DMA(1); }
            for (int t = 0; t < NT; ++t) {
                if (!late) { WAITBAR(); if (t + 1 < NT) ATT_DMA(t + 1); }
                asm volatile("" : "+v"(ia.rb0), "+v"(ia.rb1), "+v"(ia.tb0), "+v"(ia.tb1));
                const bool act = (MODE != 2) && (64 * t <= q0 + 32 * wid + 31);
                bf16x8 pa0, pa1, pa2, pa3; float alpha = 1.f;
                if (act) {
                    f32x16 p0 = {}, p1 = {};
                    { const unsigned kb0 = lds0 + KN_OFF + (t & 1) * 16384 + ia.rb0, kb1 = lds0 + KN_OFF + (t & 1) * 16384 + ia.rb1;
                      const unsigned rb0_ = lds0 + KR_OFF + (t & 1) * 8192 + ia.rb0, rb1_ = lds0 + KR_OFF + (t & 1) * 8192 + ia.rb1;
                      bf16x8 kf[3][2], qf[3];
#define ATT_KRD(i, slot) do { if ((i) < 8) { const unsigned ad_ = (((i) & 1) ? kb1 : kb0) + 512 * ((i) >> 1); kf[slot][0] = RD128(ad_); kf[slot][1] = RD128(ad_ + 8192); } \
                              else if ((i) < 12) { const unsigned ad_ = ((((i) - 8) & 1) ? rb1_ : rb0_) + 512 * (((i) - 8) >> 1); kf[slot][0] = RD128(ad_); kf[slot][1] = RD128(ad_ + 1024); qf[slot] = RD128(qrl + ((i) - 8) * 1024); } } while (0)
                      ATT_KRD(0, 0); ATT_KRD(1, 1);
#pragma unroll
                      for (int i = 0; i < 12; ++i) {
                        ATT_KRD(i + 2, (i + 2) % 3);
                        const bf16x8 qo = (i < 8) ? qn[i < 8 ? i : 0] : qf[i % 3];
                        p0 = MFMA32(kf[i % 3][0], qo, p0); p1 = MFMA32(kf[i % 3][1], qo, p1); SBAR(); }
#undef ATT_KRD
                    }
                    if (64 * t + 63 > q0 + 32 * wid) { const int dq = qrow - 64 * t - 4 * hi; const float NEG = -__builtin_inff();
#pragma unroll
                        for (int r = 0; r < 16; ++r) { const int c_ = (r & 3) + 8 * (r >> 2); if (c_ > dq) p0[r] = NEG; if (c_ + 32 > dq) p1[r] = NEG; } }
                    float pmax = p0[0];
#pragma unroll
                    for (int r = 1; r < 16; ++r) pmax = fmaxf(pmax, p0[r]);
#pragma unroll
                    for (int r = 0; r < 16; ++r) pmax = fmaxf(pmax, p1[r]);
                    { auto rr = __builtin_amdgcn_permlane32_swap(__float_as_uint(pmax), __float_as_uint(pmax), false, false); pmax = fmaxf(__uint_as_float(rr[0]), __uint_as_float(rr[1])); }
                    if (!__all((pmax - m_reg) * SCALE <= THR)) { const float mn = fmaxf(m_reg, pmax); alpha = __builtin_amdgcn_exp2f((m_reg - mn) * C2); m_reg = mn;
                        if (hi == 0) wsf[r32] = alpha; LDS_WAIT();
#pragma unroll
                        for (int d_ = 0; d_ < 4; ++d_)
#pragma unroll
                            for (int r = 0; r < 16; ++r) o[d_][r] *= wsf[crow(r, hi)]; }
                    const float mnL = -m_reg * C2; float ps = 0.f;
#pragma unroll
                    for (int r = 0; r < 16; ++r) { p0[r] = __builtin_amdgcn_exp2f(fmaf(p0[r], C2, mnL)); p1[r] = __builtin_amdgcn_exp2f(fmaf(p1[r], C2, mnL)); ps += p0[r] + p1[r]; }
                    l_reg = l_reg * alpha + ps;
                    PK4(p0, 0, pa0); PK4(p0, 8, pa1); PK4(p1, 0, pa2); PK4(p1, 8, pa3); SBAR();
                }
                if (late) { WAITBAR(); if (t + 2 < NT) ATT_DMA(t + 2); }
                if (act) {
                    const unsigned vs_ = (unsigned)t % 3u; const unsigned vb0 = lds0 + VT_OFF + vs_ * 16384 + ia.tb0, vb1 = lds0 + VT_OFF + vs_ * 16384 + ia.tb1;
                    bf16x8 vc0 = mk8(tr_read(vb0), tr_read(vb1)), vc1 = mk8(tr_read(vb0 + 4096), tr_read(vb1 + 4096)), vc2 = mk8(tr_read(vb0 + 8192), tr_read(vb1 + 8192)), vc3 = mk8(tr_read(vb0 + 12288), tr_read(vb1 + 12288)), vn0, vn1, vn2, vn3;
#pragma unroll
                    for (int dv = 0; dv < 4; ++dv) {
                        if (dv < 3) { const unsigned o_ = 512 * (dv + 1); vn0 = mk8(tr_read(vb0 + o_), tr_read(vb1 + o_)); vn1 = mk8(tr_read(vb0 + o_ + 4096), tr_read(vb1 + o_ + 4096)); vn2 = mk8(tr_read(vb0 + o_ + 8192), tr_read(vb1 + o_ + 8192)); vn3 = mk8(tr_read(vb0 + o_ + 12288), tr_read(vb1 + o_ + 12288)); }
                        o[dv] = MFMA32(pa0, vc0, o[dv]); o[dv] = MFMA32(pa1, vc1, o[dv]); o[dv] = MFMA32(pa2, vc2, o[dv]); o[dv] = MFMA32(pa3, vc3, o[dv]); vc0 = vn0; vc1 = vn1; vc2 = vn2; vc3 = vn3; SBAR(); }
                }
            }
            if (!late) WAITBAR();
            { auto rr = __builtin_amdgcn_permlane32_swap(__float_as_uint(l_reg), __float_as_uint(l_reg), false, false); l_reg = __uint_as_float(rr[0]) + __uint_as_float(rr[1]); }
            if (hi == 0) wsf[32 + r32] = l_reg; LDS_WAIT();
            LAS bf16* stg = (LAS bf16*)(L + wid * 4096);
#pragma unroll
            for (int ps_ = 0; ps_ < 2; ++ps_) {
                v4u gvs[4];
#pragma unroll
                for (int i = 0; i < 4; ++i) { const int row = i * 4 + (lane >> 4), ch = lane & 15; const size_t mrow = rowbase + q0 + 32 * wid + 16 * ps_ + row; gvs[i] = *(const GAS v4u*)(PROJ + mrow * NP + PC_GATTN + h * 128 + ch * 8); }
#pragma unroll
                for (int r8 = 0; r8 < 8; ++r8) { const int r = 8 * ps_ + r8, orow = crow(r, hi); const float rl = __builtin_amdgcn_rcpf(wsf[32 + orow]);
#pragma unroll
                    for (int dv = 0; dv < 4; ++dv) stg[(orow - 16 * ps_) * 128 + dv * 32 + r32] = (bf16)f2bf(o[dv][r] * rl); }
                LDS_WAIT();
#pragma unroll
                for (int i = 0; i < 4; ++i) { const int row = i * 4 + (lane >> 4), ch = lane & 15; const v4u ov = *(const LAS v4u*)(stg + row * 128 + ch * 8);
                    const size_t mrow = rowbase + q0 + 32 * wid + 16 * ps_ + row;
                    const v4u gv = gvs[i];
                    v4u yv; yv.x = pk2(bflo(ov.x) * silu_(bflo(gv.x)), bfhi(ov.x) * silu_(bfhi(gv.x))); yv.y = pk2(bflo(ov.y) * silu_(bflo(gv.y)), bfhi(ov.y) * silu_(bfhi(gv.y)));
                    yv.z = pk2(bflo(ov.z) * silu_(bflo(gv.z)), bfhi(ov.z) * silu_(bfhi(gv.z))); yv.w = pk2(bflo(ov.w) * silu_(bflo(gv.w)), bfhi(ov.w) * silu_(bfhi(gv.w)));
                    if (MODE == 0) *(GAS v4u*)(O + mrow * 4096 + h * 128 + ch * 8) = yv; else if (yv.x == 0x12345678u) *(GAS v4u*)(O + mrow * 4096 + h * 128 + ch * 8) = yv; }
                LDS_WAIT();
            }
            asm volatile("s_waitcnt lgkmcnt(0)\n\ts_barrier" ::: "memory");
#undef ATT_DMA
        }
    }
#undef WAITBAR
}
}

namespace att8 {
constexpr int KN_OFF = 0, KR_OFF = 16384, VT_OFF = 24576, ST_OFF = 49152, WS_OFF = SSD_TAB_OFF;
constexpr float SCALE = 0.07216878364870322f, C2 = SCALE * 1.4426950408889634f, THR = 3.f;
typedef int v8i __attribute__((ext_vector_type(8)));
#define Y8(o, g) __builtin_amdgcn_fmed3f(16.f * (o) * silu_(g), -448.f, 448.f)
#define MFMA8(A, B, C, SA) __builtin_amdgcn_mfma_scale_f32_32x32x64_f8f6f4(A, B, C, 0, 0, 0, SA, 0, 0x7F7F7F7F)
__device__ __forceinline__ v8i rd32(unsigned a0, unsigned a1) { const v4u x = *(const LAS v4u*)(uintptr_t)a0, y = *(const LAS v4u*)(uintptr_t)a1; return (v8i){(int)x.x, (int)x.y, (int)x.z, (int)x.w, (int)y.x, (int)y.y, (int)y.z, (int)y.w}; }

template <int MODE = 0>
__device__ __forceinline__ void attn_phase(Frame& F, const Args& a) {
    unsigned char* ws = a.ws;
    const unsigned char* QN8 = ws + WS_QN8; const unsigned char* QR8 = ws + WS_QR8; const unsigned char* K8 = ws + WS_K8; const unsigned char* VT8 = ws + WS_VT8; const unsigned char* KR8 = ws + WS_KR8;
    const bf16* PROJ = (const bf16*)(ws + WS_PROJ); unsigned char* O8 = ws + WS_O;
    const int wid = F.wave;
    const bool late = wid >= 4;
    const unsigned lds0 = (unsigned)(uintptr_t)F.lds; LAS unsigned char* L = F.lds;
    LAS float* wsf = (LAS float*)(L + WS_OFF) + wid * 64;
    const unsigned kdst0 = (unsigned)__builtin_amdgcn_readfirstlane(lds0 + KN_OFF + wid * 1024), vdst0 = (unsigned)__builtin_amdgcn_readfirstlane(lds0 + VT_OFF + wid * 1024), rdst0 = (unsigned)__builtin_amdgcn_readfirstlane(lds0 + KR_OFF + (wid & 3) * 1024);
#define WAITBAR() asm volatile("s_waitcnt vmcnt(0) lgkmcnt(0)\n\ts_barrier" ::: "memory")
    for (int v = F.vcu; v < 256; v += F.G) {
        const int bh = v >> 2, s4 = v & 3, b = bh >> 5, h = bh & 31; const size_t rowbase = (size_t)b * SEQ;
        for (int ui = 0; ui < 8; ++ui) {
            int lane = F.lane; asm volatile("" : "+v"(lane));
            const int r32 = lane & 31, hi = lane >> 5;
            const unsigned fk = (r32 >> 1) & 7, gk = (r32 >> 2) & 3;
            const unsigned ka00 = r32 * 128 + 16 * ((2 * hi) ^ fk), ka01 = r32 * 128 + 16 * ((2 * hi + 1) ^ fk), ka10 = r32 * 128 + 16 * ((4 + 2 * hi) ^ fk), ka11 = r32 * 128 + 16 * ((5 + 2 * hi) ^ fk);
            const unsigned rv0 = r32 * 64 + 16 * ((2 * hi) ^ gk), rv1 = r32 * 64 + 16 * ((2 * hi + 1) ^ gk);
            unsigned koff, voff, roff;
            { const int row = 8 * wid + (lane >> 3), ch = (lane & 7) ^ ((row >> 1) & 7); koff = (unsigned)((rowbase + row) * 4096 + h * 128 + ch * 16); }
            { const int d = 16 * wid + (lane >> 2), ch = (lane & 3) ^ ((d >> 2) & 3); voff = (unsigned)(((size_t)(b * 32 + h) * 128 + d) * 8192 + ch * 16); }
            { const int key = 16 * (wid & 3) + (lane >> 2), ch = (lane & 3) ^ ((key >> 2) & 3); roff = (unsigned)((rowbase + key) * 64 + ch * 16); }
            const int qb = (ui & 1) ? (31 - (s4 + 4 * (ui >> 1))) : (s4 + 4 * (ui >> 1));
            const int q0 = qb * 256, NT = 4 * qb + 4, qrow = q0 + 32 * wid + r32;
            v8i qf0, qf1, qf2;
            { const unsigned char* qp = QN8 + (rowbase + qrow) * 4096 + h * 128 + hi * 32; const v4u x0 = *(const GAS v4u*)qp, x1 = *(const GAS v4u*)(qp + 16), y0 = *(const GAS v4u*)(qp + 64), y1 = *(const GAS v4u*)(qp + 80);
              const unsigned char* rp = QR8 + (rowbase + qrow) * 2048 + h * 64 + hi * 32; const v4u z0 = *(const GAS v4u*)rp, z1 = *(const GAS v4u*)(rp + 16);
              qf0 = (v8i){(int)x0.x, (int)x0.y, (int)x0.z, (int)x0.w, (int)x1.x, (int)x1.y, (int)x1.z, (int)x1.w}; qf1 = (v8i){(int)y0.x, (int)y0.y, (int)y0.z, (int)y0.w, (int)y1.x, (int)y1.y, (int)y1.z, (int)y1.w};
              qf2 = (v8i){(int)z0.x, (int)z0.y, (int)z0.z, (int)z0.w, (int)z1.x, (int)z1.y, (int)z1.z, (int)z1.w};
              asm volatile("" : "+v"(qf0), "+v"(qf1), "+v"(qf2)); }
            unsigned dks = 0, dvs = 0;
#define ATT_DMA() do { if (MODE == 1) break; \
                glds16(K8, koff, kdst0 + dks * 8192u); glds16(VT8, voff, vdst0 + dvs * 8192u); if (wid < 4) glds16(KR8, roff, rdst0 + dks * 4096u); \
                koff += 64u * 4096u; voff += 64u; roff += 64u * 64u; dks ^= 1u; dvs = (dvs == 2u) ? 0u : dvs + 1u; } while (0)
            float m_reg = -1e30f, l_reg = 0.f; f32x16 o[4] = {};
            ATT_DMA();
            if (late) { WAITBAR(); if (1 < NT) ATT_DMA(); }
            unsigned cks = 0, cvs = 0;
            for (int t = 0; t < NT; ++t) {
                if (!late) { WAITBAR(); if (t + 1 < NT) ATT_DMA(); }
                const bool act = (MODE != 2) && (64 * t <= q0 + 32 * wid + 31);
                v8i pa; float alpha = 1.f;
                if (act) {
                    f32x16 p0 = {}, p1 = {};
                    { const unsigned kb = lds0 + KN_OFF + cks * 8192, rb = lds0 + KR_OFF + cks * 4096;
                      unsigned a00 = kb + ka00, a01 = kb + ka01, a10 = kb + ka10, a11 = kb + ka11, b0_ = rb + rv0, b1_ = rb + rv1;
                      asm volatile("" : "+v"(a00), "+v"(a01), "+v"(a10), "+v"(a11), "+v"(b0_), "+v"(b1_));
                      const v8i k00 = rd32(a00, a01), k10 = rd32(a00 + 4096, a01 + 4096);
                      const v8i k01 = rd32(a10, a11), k11 = rd32(a10 + 4096, a11 + 4096);
                      const v8i k02 = rd32(b0_, b1_), k12 = rd32(b0_ + 2048, b1_ + 2048);
                      p0 = MFMA8(k00, qf0, p0, 0x7F7F7F7F); p1 = MFMA8(k10, qf0, p1, 0x7F7F7F7F);
                      p0 = MFMA8(k01, qf1, p0, 0x7F7F7F7F); p1 = MFMA8(k11, qf1, p1, 0x7F7F7F7F);
                      p0 = MFMA8(k02, qf2, p0, 0x7F7F7F7F); p1 = MFMA8(k12, qf2, p1, 0x7F7F7F7F); }
                    if (64 * t + 63 > q0 + 32 * wid) { const int dq = qrow - 64 * t - 4 * hi; const float NEG = -__builtin_inff();
#pragma unroll
                        for (int r = 0; r < 16; ++r) { const int c_ = (r & 3) + 8 * (r >> 2); if (c_ > dq) p0[r] = NEG; if (c_ + 32 > dq) p1[r] = NEG; } }
                    float pmax = p0[0];
#pragma unroll
                    for (int r = 1; r < 16; ++r) pmax = fmaxf(pmax, p0[r]);
#pragma unroll
                    for (int r = 0; r < 16; ++r) pmax = fmaxf(pmax, p1[r]);
                    { auto rr = __builtin_amdgcn_permlane32_swap(__float_as_uint(pmax), __float_as_uint(pmax), false, false); pmax = fmaxf(__uint_as_float(rr[0]), __uint_as_float(rr[1])); }
                    if (!__all((pmax - m_reg) * SCALE <= THR)) { const float mn = fmaxf(m_reg, pmax); alpha = __builtin_amdgcn_exp2f((m_reg - mn) * C2); m_reg = mn;
                        if (hi == 0) wsf[r32] = alpha; LDS_WAIT();
#pragma unroll
                        for (int d_ = 0; d_ < 4; ++d_)
#pragma unroll
                            for (int r = 0; r < 16; ++r) o[d_][r] *= wsf[crow(r, hi)]; }
                    const float mnL = 4.0f - m_reg * C2; float ps = 0.f;
#pragma unroll
                    for (int r = 0; r < 16; ++r) { p0[r] = __builtin_amdgcn_exp2f(fmaf(p0[r], C2, mnL)); p1[r] = __builtin_amdgcn_exp2f(fmaf(p1[r], C2, mnL)); ps += p0[r] + p1[r]; }
                    l_reg = l_reg * alpha + ps;
#pragma unroll
                    for (int k = 0; k < 4; ++k) { pa[k] = (int)pg8::pk4_fp8(p0[4 * k], p0[4 * k + 1], p0[4 * k + 2], p0[4 * k + 3]); pa[4 + k] = (int)pg8::pk4_fp8(p1[4 * k], p1[4 * k + 1], p1[4 * k + 2], p1[4 * k + 3]); }
                    SBAR();
                }
                if (late) { WAITBAR(); if (t + 2 < NT) ATT_DMA(); }
                if (act) {
                    const unsigned vb = lds0 + VT_OFF + cvs * 8192;
                    unsigned c0_ = vb + rv0, c1_ = vb + rv1; asm volatile("" : "+v"(c0_), "+v"(c1_));
                    const v8i v0_ = rd32(c0_, c1_), v1_ = rd32(c0_ + 2048, c1_ + 2048), v2_ = rd32(c0_ + 4096, c1_ + 4096), v3_ = rd32(c0_ + 6144, c1_ + 6144);
                    o[0] = MFMA8(pa, v0_, o[0], 0x7B7B7B7B); o[1] = MFMA8(pa, v1_, o[1], 0x7B7B7B7B); o[2] = MFMA8(pa, v2_, o[2], 0x7B7B7B7B); o[3] = MFMA8(pa, v3_, o[3], 0x7B7B7B7B);
                    SBAR();
                }
                cks ^= 1u; cvs = (cvs == 2u) ? 0u : cvs + 1u;
            }
            if (!late) WAITBAR();
            { auto rr = __builtin_amdgcn_permlane32_swap(__float_as_uint(l_reg), __float_as_uint(l_reg), false, false); l_reg = __uint_as_float(rr[0]) + __uint_as_float(rr[1]); }
            if (hi == 0) wsf[32 + r32] = l_reg; LDS_WAIT();
            LAS bf16* stg = (LAS bf16*)(L + ST_OFF + wid * 4096);
#pragma unroll
            for (int ps_ = 0; ps_ < 2; ++ps_) {
                v4u gvs[4];
#pragma unroll
                for (int i = 0; i < 4; ++i) { const int row = i * 4 + (lane >> 4), ch = lane & 15; const size_t mrow = rowbase + q0 + 32 * wid + 16 * ps_ + row; gvs[i] = *(const GAS v4u*)(PROJ + mrow * NP + PC_GATTN + h * 128 + ch * 8); }
#pragma unroll
                for (int r8 = 0; r8 < 8; ++r8) { const int r = 8 * ps_ + r8, orow = crow(r, hi); const float rl = 16.0f * __builtin_amdgcn_rcpf(wsf[32 + orow]);
#pragma unroll
                    for (int dv = 0; dv < 4; ++dv) stg[(orow - 16 * ps_) * 128 + dv * 32 + r32] = (bf16)f2bf(o[dv][r] * rl); }
                LDS_WAIT();
#pragma unroll
                for (int i = 0; i < 4; ++i) { const int row = i * 4 + (lane >> 4), ch = lane & 15; const v4u ov = *(const LAS v4u*)(stg + row * 128 + ch * 8);
                    const size_t mrow = rowbase + q0 + 32 * wid + 16 * ps_ + row;
                    const v4u gv = gvs[i];
                    v2u yv;
                    yv.x = pg8::pk4_fp8(Y8(bflo(ov.x), bflo(gv.x)), Y8(bfhi(ov.x), bfhi(gv.x)), Y8(bflo(ov.y), bflo(gv.y)), Y8(bfhi(ov.y), bfhi(gv.y)));
                    yv.y = pg8::pk4_fp8(Y8(bflo(ov.z), bflo(gv.z)), Y8(bfhi(ov.z), bfhi(gv.z)), Y8(bflo(ov.w), bflo(gv.w)), Y8(bfhi(ov.w), bfhi(gv.w)));
                    if (MODE == 0) *(GAS v2u*)(O8 + mrow * 4096 + h * 128 + ch * 8) = yv; else if (yv.x == 0x12345678u) *(GAS v2u*)(O8 + mrow * 4096 + h * 128 + ch * 8) = yv; }
                LDS_WAIT();
            }
            asm volatile("s_waitcnt lgkmcnt(0)\n\ts_barrier" ::: "memory");
#undef ATT_DMA
        }
    }
#undef WAITBAR
}
#undef MFMA8
}

__device__ __forceinline__ void late_weights(Frame& F, const Args& a, int gw, int NGW) {
    unsigned char* ws = a.ws;
    LAS float* scr = (LAS float*)(F.lds + RING_OFF + F.wave * 16384);
    constexpr int I_BS = (D_SSM / 64) * (DM / 32), I_BA = (DM / 64) * (DM / 32), I_OUT = I_BA;
    auto dec = [&](int it) -> TItem {
        int r = it;
        if (r < I_BS) return TItem{a.w_bs, ws + WS_WBS, nullptr, D_SSM, DM, D_SSM * 2, DM / 32, r, 4, 1.0f, false}; r -= I_BS;
        if (r < I_BA) return TItem{a.w_ba, ws + WS_WBA, nullptr, DM, DM, DM, DM / 32, r, 4, 64.0f, true}; r -= I_BA;
        return TItem{a.w_out, ws + WS_WOUT, nullptr, DM, DM, DM * 2, DM / 32, r, 4, 1.0f, false}; };
    transpose_stream(dec, I_BS + I_BA + I_OUT, gw, NGW, F.lane, scr);
}
__device__ __forceinline__ void p6_thin(Frame& F, const Args& a, bool dry = false) {
    unsigned char* ws = a.ws; const bf16* PROJ = (const bf16*)(ws + WS_PROJ); bf16* XBC = (bf16*)(ws + WS_XBC);
    const int gw = F.vcu * NWAVES + F.wave, NGW = F.G * NWAVES;
    const int g0 = (gw * 4) & 7;
    f32x4 wq[4][4];
#pragma unroll
    for (int u = 0; u < 4; ++u)
#pragma unroll
        for (int q = 0; q < 4; ++q) wq[u][q] = *(const GAS f32x4*)(a.ssm_norm_w + (g0 + u) * 1024 + F.lane * 16 + 4 * q);
    for (int it0 = gw * 4; it0 < M * NG; it0 += NGW * 4) {
        v4u y0[4], y1[4], z0[4], z1[4];
#pragma unroll
        for (int u = 0; u < 4; ++u) { const int it = it0 + u, m = it >> 3, g = it & 7; const bf16* yp = XBC + (size_t)m * D_CONV + g * 1024 + F.lane * 16; const bf16* zp = PROJ + (size_t)m * NP + PC_Z + g * 1024 + F.lane * 16;
            y0[u] = *(const GAS v4u*)yp; y1[u] = *(const GAS v4u*)(yp + 8); z0[u] = *(const GAS v4u*)zp; z1[u] = *(const GAS v4u*)(zp + 8); }
#pragma unroll
        for (int u = 0; u < 4; ++u) { const int it = it0 + u, m = it >> 3, g = it & 7; bf16* yp = XBC + (size_t)m * D_CONV + g * 1024 + F.lane * 16;
            float v[16]; float s = 0.f;
#pragma unroll
            for (int j = 0; j < 4; ++j) { v[2 * j] = bflo(y0[u][j]) * silu_(bflo(z0[u][j])); v[2 * j + 1] = bfhi(y0[u][j]) * silu_(bfhi(z0[u][j])); v[8 + 2 * j] = bflo(y1[u][j]) * silu_(bflo(z1[u][j])); v[8 + 2 * j + 1] = bfhi(y1[u][j]) * silu_(bfhi(z1[u][j])); }
#pragma unroll
            for (int j = 0; j < 16; ++j) s += v[j] * v[j];
            const float rstd = 1.0f / sqrtf(wave_sum(s) * (1.f / 1024.f) + EPS);
            v4u o0, o1;
#pragma unroll
            for (int j = 0; j < 4; ++j) { o0[j] = pk2(v[2 * j] * rstd * wq[u][j >> 1][(2 * j) & 3], v[2 * j + 1] * rstd * wq[u][j >> 1][(2 * j + 1) & 3]); o1[j] = pk2(v[8 + 2 * j] * rstd * wq[u][2 + (j >> 1)][(2 * j) & 3], v[8 + 2 * j + 1] * rstd * wq[u][2 + (j >> 1)][(2 * j + 1) & 3]); }
            if (!dry) { *(GAS v4u*)yp = o0; *(GAS v4u*)(yp + 8) = o1; } }
    }
}
__device__ __forceinline__ void p9_final(Frame& F, const Args& a, bool dry = false) {
    const int gw = F.vcu * NWAVES + F.wave, NGW = F.G * NWAVES; const bf16* H = (const bf16*)(a.ws + WS_H16);
    f32x4 w0[8], w1[8];
    { const GAS f32x4* wr = (const GAS f32x4*)a.norm_final_w;
#pragma unroll
      for (int j = 0; j < 8; ++j) { const int c4 = 2 * (F.lane + 64 * j); w0[j] = wr[c4]; w1[j] = wr[c4 + 1]; } }
    v4u hv[8];
    if (gw < M) { const GAS v4u* hr = (const GAS v4u*)(H + (size_t)gw * DM) + F.lane;
#pragma unroll
        for (int j = 0; j < 8; ++j) hv[j] = hr[64 * j]; }
    for (int m = gw; m < M; m += NGW) {
        v4u hn[8]; const int mn = (m + NGW < M) ? m + NGW : m;
        { const GAS v4u* hr = (const GAS v4u*)(H + (size_t)mn * DM) + F.lane;
#pragma unroll
          for (int j = 0; j < 8; ++j) hn[j] = hr[64 * j]; }
        float s = 0.f;
#pragma unroll
        for (int j = 0; j < 8; ++j)
#pragma unroll
            for (int e = 0; e < 4; ++e) { const float lo = bflo(hv[j][e]), hi_ = bfhi(hv[j][e]); s += lo * lo + hi_ * hi_; }
        const float rstd = 1.0f / sqrtf(wave_sum(s) * (1.f / DM) + EPS);
        GAS f32x4* orow = (GAS f32x4*)(a.out + (size_t)m * DM);
#pragma unroll
        for (int j = 0; j < 8; ++j) { const int c4 = 2 * (F.lane + 64 * j);
            f32x4 o0, o1; o0.x = bflo(hv[j].x) * rstd * w0[j].x; o0.y = bfhi(hv[j].x) * rstd * w0[j].y; o0.z = bflo(hv[j].y) * rstd * w0[j].z; o0.w = bfhi(hv[j].y) * rstd * w0[j].w;
            o1.x = bflo(hv[j].z) * rstd * w1[j].x; o1.y = bfhi(hv[j].z) * rstd * w1[j].y; o1.z = bflo(hv[j].w) * rstd * w1[j].z; o1.w = bfhi(hv[j].w) * rstd * w1[j].w;
            if (!dry) { orow[c4] = o0; orow[c4 + 1] = o1; } }
#pragma unroll
        for (int j = 0; j < 8; ++j) hv[j] = hn[j];
    }
}

constexpr int NPHASE = 10;
__global__ void __launch_bounds__(NWAVES * 64, 2) mk_fwd(Args args) {
    extern __shared__ __attribute__((aligned(16))) unsigned char lds[];
    Frame F;
    F.lds = (LAS unsigned char*)lds;
    F.MISC = (volatile LAS unsigned*)(F.lds + MISC_OFF);
    F.tid = threadIdx.x; F.lane = F.tid & 63; F.wave = __builtin_amdgcn_readfirstlane(F.tid >> 6);
    F.G = gridDim.x; { const int bx = blockIdx.x; F.vcu = (F.G % 8 == 0) ? (bx % 8) * (F.G / 8) + bx / 8 : bx; }
    unsigned char* ws = args.ws;
    F.ctl = (gu32*)(ws + WS_CTL);
    for (int u = F.tid; u < 512 / 4; u += NWAVES * 64) ((LAS unsigned*)(F.lds + LDSCTL_OFF))[u] = 0u;
    __syncthreads();
    const int lo = args.ph_lo, hi = args.ph_hi;
    const bool multi = (hi - lo) > 1;
    XcdBarrier bar; bar.bar = (unsigned*)(F.ctl + CW_BAR); bar.x = 0; bar.st = nullptr;
    if (multi) bar = xcd_barrier_post((unsigned*)(F.ctl + CW_BAR), F.MISC + 8);
#ifndef PH_MASK
#define PH_MASK 0x3ff
#endif
#define IN(k) (((PH_MASK >> (k)) & 1) && lo <= (k) && (k) < hi)
#define BOTH(k) (IN(k) && IN((k) + 1))
#define GRID_BAR() xcd_barrier(bar)
    typedef pg8::bf16_t b16;
#ifndef PROBE_DUP
#define PROBE_DUP -1
#endif
#ifndef P1_SP2
#define P1_SP2 true
#endif
#define DUP(k, BODY) do { BODY; if (PROBE_DUP == (k)) { GRID_BAR(); BODY; } } while (0)
#define P1_BODY do { \
        { pg8::Gemm g{(const b16*)(ws + WS_U), (const b16*)(ws + WS_WIN), M, N16, DM, DM, DM}; pg8::StaticOrder S; S.init(M, N16, F.G, (int)blockIdx.x); \
          pg8::EpiProj E{(b16*)(ws + WS_PROJ), NP, (float*)(ws + WS_DT32), GC_DT / 256}; \
          pg8::gemm_phase<pg8::EpiProj, pg8::StaticOrder, 0, P1_SP2>(F.lds + RING_OFF, g, S, E); } \
        { pg8::Gemm g{(const b16*)(ws + WS_U8), (const b16*)(ws + WS_WIN8), M, N8, DM / 2, DM / 2, DM / 2, 0x7F7F7F7F, 0x79797979};     \
          const int r16_ = ((M / 256) * (N16 / 256)) % F.G;                        \
          pg8::StaticOrder S; S.init(M, N8, F.G, (int)((blockIdx.x + F.G - r16_) % F.G)); \
          pg8::EpiProj8 E{(b16*)(ws + WS_PROJ) + PC_A0, NP, ws + WS_CQ8, ws + WS_KV8, (PC_CQ - PC_A0) / 256, (PC_KV - PC_A0) / 256}; \
          pg8::gemm_phase<pg8::EpiProj8, pg8::StaticOrder, 0, true, true>(F.lds + RING_OFF, g, S, E); \
          __syncthreads(); \
          if (r16_ == 0) late_weights(F, args, (int)blockIdx.x * NWAVES + F.wave, F.G * NWAVES); \
          else if ((int)blockIdx.x >= r16_) late_weights(F, args, ((int)blockIdx.x - r16_) * NWAVES + F.wave, (F.G - r16_) * NWAVES); } } while (0)
#define P3_BODY do { \
          \
        { pg8::Gemm g{(const b16*)(ws + WS_CQ8), (const b16*)(ws + WS_WUQ), M, 6144, Q_LORA / 2, Q_LORA / 2, Q_LORA / 2, 0x7F7F7F7F, 0x7A7A7A7A}; pg8::StaticOrder S; S.init(M, 6144, F.G, (int)blockIdx.x); \
          pg8::EpiQ8 E{ws + WS_QN8, ws + WS_QR8, (const float*)(ws + WS_RSTDQ), (const float*)(ws + WS_COS), (const float*)(ws + WS_SIN)}; \
          pg8::gemm_phase<pg8::EpiQ8, pg8::StaticOrder, 0, true, true>(F.lds + RING_OFF, g, S, E); } \
        { pg8::Gemm g{(const b16*)(ws + WS_KV8), (const b16*)(ws + WS_WUKV), M, 4096, KV_LORA / 2, KV_LORA / 2, KV_LORA / 2, 0x7F7F7F7F, 0x7A7A7A7A}; pg8::StaticOrder S; S.init(M, 4096, F.G, (int)blockIdx.x); \
          pg8::EpiK8 E{ws + WS_K8, (const float*)(ws + WS_RSTDKV)}; \
          pg8::gemm_phase<pg8::EpiK8, pg8::StaticOrder, 0, true, true>(F.lds + RING_OFF, g, S, E); } \
        { pg8::Gemm g{(const b16*)(ws + WS_WUKV + (size_t)4096 * KV_LORA), (const b16*)(ws + WS_KV8), 4096, M, KV_LORA / 2, KV_LORA / 2, KV_LORA / 2, 0x7A7A7A7A, 0x7F7F7F7F}; pg8::StaticOrder S; S.init(4096, M, F.G, (int)blockIdx.x); \
          pg8::EpiVT8 E{ws + WS_VT8, (const float*)(ws + WS_RSTDKV)}; \
          pg8::gemm_phase<pg8::EpiVT8, pg8::StaticOrder, 0, true, true>(F.lds + RING_OFF, g, S, E); } } while (0)
#define P7_BODY do { \
        { pg8::Gemm g{(const b16*)(ws + WS_O), (const b16*)(ws + WS_WBA), M, DM, DM / 2, DM / 2, DM / 2, 0x7B7B7B7B, 0x79797979};     \
          pg8::StaticOrder S; S.init(M, DM, F.G, (int)blockIdx.x); \
          pg8::EpiGate<false> E{(b16*)(ws + WS_MERGED), (const b16*)(ws + WS_PROJ) + PC_GATT2, NP}; \
          pg8::gemm_phase<pg8::EpiGate<false>, pg8::StaticOrder, 0, true, true>(F.lds + RING_OFF, g, S, E); } \
        { pg8::Gemm g{(const b16*)(ws + WS_XBC), (const b16*)(ws + WS_WBS), M, DM, D_SSM, D_CONV, D_SSM}; pg8::StaticOrder S; S.init(M, DM, F.G, (int)blockIdx.x); \
          pg8::EpiGate<true> E{(b16*)(ws + WS_MERGED), (const b16*)(ws + WS_PROJ) + PC_GSSM, NP}; \
          pg8::gemm_phase<pg8::EpiGate<true>, pg8::StaticOrder>(F.lds + RING_OFF, g, S, E); } } while (0)
#define P8_BODY do { pg8::Gemm g{(const b16*)(ws + WS_MERGED), (const b16*)(ws + WS_WOUT), M, DM, DM, DM, DM}; pg8::StaticOrder S; S.init(M, DM, F.G, (int)blockIdx.x); \
        pg8::EpiOut E{(b16*)(ws + WS_H16), args.x}; \
        pg8::gemm_phase<pg8::EpiOut, pg8::StaticOrder>(F.lds + RING_OFF, g, S, E); } while (0)
    if (IN(0)) { DUP(0, p0_prologue(F, args)); if (BOTH(0)) GRID_BAR(); }
#define P1_PROBE(PV) do { pg8::Gemm g{(const b16*)(ws + WS_U), (const b16*)(ws + WS_WIN), M, N16, DM, DM, DM}; pg8::StaticOrder S; S.init(M, N16, F.G, (int)blockIdx.x); \
        pg8::EpiProj E{(b16*)(ws + WS_PROJ), NP, (float*)(ws + WS_DT32), GC_DT / 256}; \
        pg8::gemm_phase<pg8::EpiProj, pg8::StaticOrder, PV>(F.lds + RING_OFF, g, S, E); } while (0)
    if (IN(1)) { if (PROBE_DUP == 11) { P1_PROBE(1); GRID_BAR(); } if (PROBE_DUP == 12) { P1_PROBE(2); GRID_BAR(); } if (PROBE_DUP == 13) { P1_PROBE(3); GRID_BAR(); } DUP(1, P1_BODY); if (BOTH(1)) GRID_BAR(); }
    if (IN(2)) { DUP(2, p2_thin(F, args)); if (BOTH(2)) GRID_BAR(); if (PROBE_DUP == 50) { for (int i_ = 0; i_ < 20; ++i_) GRID_BAR(); } }
    if (IN(3)) { DUP(3, P3_BODY);   }
    if (IN(4)) { if (PROBE_DUP == 41) { ssd::ssd_phase<0>(F, args, true); GRID_BAR(); } if (PROBE_DUP == 42) { ssd::ssd_phase<2>(F, args, true); GRID_BAR(); } if (PROBE_DUP == 43) { ssd::ssd_phase<3>(F, args, true); GRID_BAR(); } if (PROBE_DUP == 44) { ssd::ssd_phase<4>(F, args, true); GRID_BAR(); }
        ssd::ssd_phase<0>(F, args); if (BOTH(4)) GRID_BAR(); }
    if (IN(5)) { if (PROBE_DUP == 31) { att::attn_phase<1>(F, args); GRID_BAR(); } if (PROBE_DUP == 32) { att::attn_phase<2>(F, args); GRID_BAR(); } if (PROBE_DUP == 33) { att::attn_phase<3>(F, args); GRID_BAR(); }
        if (PROBE_DUP == 61) { att8::attn_phase<1>(F, args); GRID_BAR(); }
        DUP(5, att8::attn_phase<0>(F, args)); if (BOTH(5)) GRID_BAR(); }
    if (IN(6)) { if (PROBE_DUP == 6) { p6_thin(F, args, true); GRID_BAR(); } p6_thin(F, args); if (BOTH(6)) GRID_BAR(); }
    if (IN(7)) { DUP(7, P7_BODY); if (BOTH(7)) GRID_BAR(); }
    if (IN(8)) { DUP(8, P8_BODY); if (BOTH(8)) GRID_BAR(); }
    if (IN(9)) { if (PROBE_DUP == 9) { p9_final(F, args, true); GRID_BAR(); } p9_final(F, args); }
    if (PROBE_DUP == 20 && xb_xcc_id() != (blockIdx.x & 7u) && F.tid == 0) args.out[blockIdx.x] = __builtin_nanf("");
#undef IN
#undef BOTH
#undef GRID_BAR
}

#if MK_DEBUG
constexpr size_t WS_DBG = WS_END;
constexpr int DBG_NROW = 64;
__device__ __forceinline__ unsigned dh(unsigned x) { x ^= x >> 16; x *= 0x7feb352dU; x ^= x >> 15; x *= 0x846ca68bU; x ^= x >> 16; return x; }
__device__ __forceinline__ void chk_put(unsigned* w, double got, double ref, double flr, double tol) { double e = fabs(got - ref) / (tol * (fabs(ref) + flr)); float f = (float)e; if (!(f == f) || !(got == got)) f = 1e30f; atomicMax(w, __float_as_uint(f)); }
__device__ __forceinline__ int dbg_row(int i) { const int special[8] = {0, 1, 2, 3, 127, 128, 8191, 8192}; return i < 8 ? special[i] : (i < 12 ? 16383 - (i - 8) * 129 : (int)(dh(i * 7919u + 13u) % M)); }

__device__ __forceinline__ double fp8d(unsigned char v) { const int sg = v >> 7, e = (v >> 3) & 15, m = v & 7; const double x = (e == 0) ? m * 0.001953125 : (1.0 + m * 0.125) * (double)(1 << e) * 0.0078125; return sg ? -x : x; }
__device__ __forceinline__ int vtpos(int t) { const int k = t & 63; return (t & ~63) + 32 * ((k >> 2) & 1) + 16 * (k >> 5) + 4 * ((k >> 3) & 3) + (k & 3); }
__global__ void dbg_save_rows(Args a) {
    const int i = blockIdx.x, m = dbg_row(i); const bf16* src = (const bf16*)(a.ws + WS_XBC) + (size_t)m * D_CONV; bf16* dst = (bf16*)(a.ws + WS_DBG) + (size_t)i * D_CONV;
    for (int c = threadIdx.x; c < D_CONV; c += blockDim.x) dst[c] = src[c];
}
__device__ double dbg_conv(const Args& a, int m, int c) {
    const bf16* PROJ = (const bf16*)(a.ws + WS_PROJ); const int t = m & (SEQ - 1); double acc = a.conv_b[c];
    for (int k = 0; k < 4; ++k) { const int tt = t - 3 + k; if (tt >= 0) acc += (double)a.conv_w[k * D_CONV + c] * (double)bf2f(PROJ[(size_t)(m - 3 + k) * NP + PC_XBC + c]); }
    return acc / (1.0 + exp(-acc));
}
__global__ void __launch_bounds__(256) dbg_chk(Args a, int stage) {
    unsigned char* ws = a.ws; unsigned* ew = (unsigned*)(ws + WS_CTL) + CW_CHK + stage;
    const int gid = blockIdx.x * blockDim.x + threadIdx.x, tid = threadIdx.x;
    const bf16* PROJ = (const bf16*)(ws + WS_PROJ);
    __shared__ float sh[8192]; __shared__ double red[256];
    if (stage == 0) {
        if (gid < 2048) { const int m = dbg_row(gid & 63), k = dh(gid) % DM; double s = 0; for (int j = 0; j < DM; ++j) { double v = a.x[(size_t)m * DM + j]; s += v * v; }
            const double ref = a.x[(size_t)m * DM + k] / sqrt(s / DM + 1e-6) * a.norm_in_w[k]; chk_put(ew, bf2f(((const bf16*)(ws + WS_U))[(size_t)m * DM + k]), ref, 0.05, 0.006); }
        else if (gid < 4096) { const int n = (gid < 2200) ? (N16 - 1 - (gid - 2048)) : dh(gid) % N16, k = dh(gid * 3 + 1) % DM; const int sc = SrcIn16()(n); const double ref = sc >= 0 ? a.w_in[(size_t)k * D_IN + sc] : 0.0;
            chk_put(ew, bf2f(((const bf16*)(ws + WS_WIN))[(size_t)n * DM + k]), ref, 1e-3, 0.006); }
        else if (gid < 6144) { const int n = (gid < 4300) ? (N8 - 1 - (gid - 4096)) : dh(gid) % N8, k = dh(gid * 3 + 1) % DM; const int sc = SrcIn8()(n); const double ref = sc >= 0 ? a.w_in[(size_t)k * D_IN + sc] : 0.0;
            chk_put(ew, fp8d((ws + WS_WIN8)[(size_t)n * DM + k]) / 64.0, ref, 1e-3, 0.08);
            const int m = dbg_row(gid & 63); chk_put(ew, fp8d((ws + WS_U8)[(size_t)m * DM + k]), bf2f(((const bf16*)(ws + WS_U))[(size_t)m * DM + k]), 0.05, 0.08); }
        else if (gid < 8192) { const int n = dh(gid) % 6144, k = dh(gid * 3 + 1) % Q_LORA; const int sc = SrcUq()(n); chk_put(ew, fp8d((ws + WS_WUQ)[(size_t)n * Q_LORA + k]) / 32.0, (double)a.w_uq[(size_t)k * 6144 + sc] * a.q_norm_w[k], 2e-3, 0.08); }
        else if (gid < 10240) { const int n = dh(gid) % 8192, k = dh(gid * 3 + 1) % KV_LORA; chk_put(ew, fp8d((ws + WS_WUKV)[(size_t)n * KV_LORA + k]) / 32.0, (double)a.w_ukv[(size_t)k * 8192 + SrcUkv()(n)] * a.kv_norm_w[k], 2e-3, 0.08); }
        else if (gid < 14336) { const int t = (gid < 10400) ? (gid - 10240) : 1 + dh(gid) % (SEQ - 1), i = dh(gid * 5 + 2) & 31; const float* C = (const float*)(ws + WS_COS); const float* S = (const float*)(ws + WS_SIN);
            double f = 1.0; for (int k = 0; k < i; ++k) f *= 0.74989420933245582730; double cf = 1, sf = 0, term = 1; for (int k = 1; k < 24; ++k) { term *= f / k; const int q = k & 3; if (q == 1) sf += term; else if (q == 2) cf -= term; else if (q == 3) sf -= term; else cf += term; }
            if (t == 0) { chk_put(ew, C[i], 1.0, 1.0, 3e-4); chk_put(ew, S[i], 0.0, 1.0, 3e-4); } else { const double c0 = C[(t - 1) * 32 + i], s0 = S[(t - 1) * 32 + i]; chk_put(ew, C[t * 32 + i], c0 * cf - s0 * sf, 1.0, 3e-4); chk_put(ew, S[t * 32 + i], s0 * cf + c0 * sf, 1.0, 3e-4); } }
    } else if (stage == 1) {
        if (gid < 4096) { const int m = dbg_row(gid & 63); int n; const int sel = gid >> 6; if (sel < 16) n = GC_DT - 1 - sel * 50; else n = dh(gid) % GC_DT;
            const bf16* u = (const bf16*)(ws + WS_U) + (size_t)m * DM; const bf16* w = (const bf16*)(ws + WS_WIN) + (size_t)n * DM; double s = 0; for (int k = 0; k < DM; ++k) s += (double)bf2f(u[k]) * (double)bf2f(w[k]);
            chk_put(ew, bf2f(PROJ[(size_t)m * NP + n]), s, 0.25, 0.01); }
        else if (gid < 8192) { const int m = dbg_row(gid & 63); int n; const int sel = (gid - 4096) >> 6; if (sel < 16) n = N8 - 1 - sel * 50; else n = dh(gid) % N8;
            const unsigned char* u = ws + WS_U8 + (size_t)m * DM; const unsigned char* w = ws + WS_WIN8 + (size_t)n * DM; double s = 0; for (int k = 0; k < DM; ++k) s += fp8d(u[k]) * fp8d(w[k]);
            chk_put(ew, bf2f(PROJ[(size_t)m * NP + PC_A0 + n]), s / 64.0, 0.25, 0.01);
            const int kq = dh(gid * 7 + 3) & 1023, kk = dh(gid * 11 + 5) & 511;
            chk_put(ew, fp8d((ws + WS_CQ8)[(size_t)m * 1024 + kq]), bf2f(PROJ[(size_t)m * NP + PC_CQ + kq]), 0.05, 0.08); chk_put(ew, fp8d((ws + WS_KV8)[(size_t)m * 512 + kk]), bf2f(PROJ[(size_t)m * NP + PC_KV + kk]), 0.05, 0.08); }
        else if (gid < 8192 + 2048) { const int m = dbg_row(gid & 63), j = dh(gid) & 127; const bf16* u = (const bf16*)(ws + WS_U) + (size_t)m * DM; const bf16* w = (const bf16*)(ws + WS_WIN) + (size_t)(GC_DT + j) * DM; double s = 0; for (int k = 0; k < DM; ++k) s += (double)bf2f(u[k]) * (double)bf2f(w[k]);
            chk_put(ew, ((const float*)(ws + WS_DT32))[(size_t)m * 128 + j], s, 1.0, 1e-3); }
    } else if (stage == 2) {
        if (gid < 8192) { const int m = dbg_row(gid & 63), c = (gid < 4096) ? dh(gid) % D_CONV : (D_CONV - 1 - (gid & 1023)); chk_put(ew, bf2f(((const bf16*)(ws + WS_XBC))[(size_t)m * D_CONV + c]), dbg_conv(a, m, c), 0.1, 0.01); }
        else if (gid < 8192 + 64) { const int m = dbg_row(gid & 63); double sq = 0, sk = 0; for (int k = 0; k < Q_LORA; ++k) { double v = bf2f(PROJ[(size_t)m * NP + PC_CQ + k]); sq += v * v; } for (int k = 0; k < KV_LORA; ++k) { double v = bf2f(PROJ[(size_t)m * NP + PC_KV + k]); sk += v * v; }
            chk_put(ew, ((const float*)(ws + WS_RSTDQ))[m], 1.0 / sqrt(sq / Q_LORA + 1e-6), 0.0, 1e-4); chk_put(ew, ((const float*)(ws + WS_RSTDKV))[m], 1.0 / sqrt(sk / KV_LORA + 1e-6), 0.0, 1e-4); }
        else if (gid < 8192 + 64 + 2048) { const int m = dbg_row(gid & 63), i = (gid >> 6) & 31, t = m & (SEQ - 1); const double x1 = bf2f(PROJ[(size_t)m * NP + PC_KV + 512 + i]), x2 = bf2f(PROJ[(size_t)m * NP + PC_KV + 544 + i]);
            const double c = ((const float*)(ws + WS_COS))[t * 32 + i], sn = ((const float*)(ws + WS_SIN))[t * 32 + i]; const bf16* kr = (const bf16*)(ws + WS_KROPE) + (size_t)m * 64;
            chk_put(ew, bf2f(kr[2 * i]), x1 * c - x2 * sn, 0.25, 0.01); chk_put(ew, bf2f(kr[2 * i + 1]), x2 * c + x1 * sn, 0.25, 0.01);
            const unsigned char* k8 = ws + WS_KR8 + (size_t)m * 64; chk_put(ew, fp8d(k8[2 * i]), x1 * c - x2 * sn, 0.1, 0.08); chk_put(ew, fp8d(k8[2 * i + 1]), x2 * c + x1 * sn, 0.1, 0.08); }
    } else if (stage == 3) {
        const unsigned char* CQ = ws + WS_CQ8; const unsigned char* CK = ws + WS_KV8; const unsigned char* WQ = ws + WS_WUQ; const unsigned char* WK = ws + WS_WUKV;
        if (gid < 4096) { const int m = dbg_row(gid & 63), n = dh(gid) % 4096; double s = 0; for (int k = 0; k < Q_LORA; ++k) s += fp8d(CQ[(size_t)m * Q_LORA + k]) * fp8d(WQ[(size_t)n * Q_LORA + k]);
            chk_put(ew, fp8d((ws + WS_QN8)[(size_t)m * 4096 + n]), s / 32.0 * ((const float*)(ws + WS_RSTDQ))[m], 0.1, 0.08); }
        else if (gid < 8192) { const int m = dbg_row(gid & 63), pr = dh(gid) % 1024, t = m & (SEQ - 1), i = pr & 31; const int n1 = 4096 + 2 * pr, n2 = n1 + 1; double s1 = 0, s2 = 0;
            for (int k = 0; k < Q_LORA; ++k) { const double av = fp8d(CQ[(size_t)m * Q_LORA + k]); s1 += av * fp8d(WQ[(size_t)n1 * Q_LORA + k]); s2 += av * fp8d(WQ[(size_t)n2 * Q_LORA + k]); }
            const double rs = ((const float*)(ws + WS_RSTDQ))[m] / 32.0; s1 *= rs; s2 *= rs; const double c = ((const float*)(ws + WS_COS))[t * 32 + i], sn = ((const float*)(ws + WS_SIN))[t * 32 + i];
            const unsigned char* qr = ws + WS_QR8 + (size_t)m * 2048; chk_put(ew, fp8d(qr[2 * pr]), s1 * c - s2 * sn, 0.1, 0.08); chk_put(ew, fp8d(qr[2 * pr + 1]), s2 * c + s1 * sn, 0.1, 0.08); }
        else if (gid < 12288) { const int m = dbg_row(gid & 63), n = dh(gid) % 4096; double s = 0; for (int k = 0; k < KV_LORA; ++k) s += fp8d(CK[(size_t)m * KV_LORA + k]) * fp8d(WK[(size_t)n * KV_LORA + k]);
            chk_put(ew, fp8d((ws + WS_K8)[(size_t)m * 4096 + n]), s / 32.0 * ((const float*)(ws + WS_RSTDKV))[m], 0.1, 0.08); }
        else if (gid < 16384) { const int m = dbg_row(gid & 63), r = dh(gid) % 4096, bb = m >> 13, t = m & (SEQ - 1); double s = 0; for (int k = 0; k < KV_LORA; ++k) s += fp8d(CK[(size_t)m * KV_LORA + k]) * fp8d(WK[(size_t)(4096 + r) * KV_LORA + k]);
            chk_put(ew, fp8d((ws + WS_VT8)[(size_t)(bb * 4096 + r) * 8192 + vtpos(t)]), s / 32.0 * ((const float*)(ws + WS_RSTDKV))[m], 0.1, 0.08); }
    } else if (stage == 4) {
        const int si = blockIdx.x; if (si >= 96) return; const int tl[12] = {0, 1, 127, 128, 129, 255, 256, 1000, 4095, 4096, 8190, 8191};
        const int b = si & 1, hh = dh(si * 31 + 5) & 127, t = (si < 24) ? tl[si >> 1] : (int)(dh(si * 17 + 3) % SEQ), p = dh(si * 13 + 1) & 63, g = hh >> 4;
        const bf16* XBC = (const bf16*)(ws + WS_XBC); const float* DT32 = (const float*)(ws + WS_DT32); const double A = -exp((double)a.a_log[hh]);
        if (tid == 0) { double d = 0; for (int s = t; s >= 0; --s) { sh[s] = (float)d; const double dt = (double)DT32[((size_t)b * SEQ + s) * 128 + hh]; d += dt * A; } }
        __syncthreads();
        const size_t mt = (size_t)b * SEQ + t; double acc = 0;
        for (int s = tid; s <= t; s += 256) { const size_t ms = (size_t)b * SEQ + s; double cb = 0; for (int n = 0; n < 128; ++n) cb += (double)bf2f(XBC[mt * D_CONV + D_SSM + 1024 + g * 128 + n]) * (double)bf2f(XBC[ms * D_CONV + D_SSM + g * 128 + n]);
            const double dt = (double)DT32[ms * 128 + hh];
            acc += cb * exp((double)sh[s]) * dt * dbg_conv(a, (int)ms, hh * 64 + p); }
        red[tid] = acc; __syncthreads(); for (int o = 128; o > 0; o >>= 1) { if (tid < o) red[tid] += red[tid + o]; __syncthreads(); }
        if (tid == 0) { const double ref = red[0] + (double)a.d_skip[hh] * dbg_conv(a, (int)mt, hh * 64 + p); chk_put(ew, bf2f(XBC[mt * D_CONV + hh * 64 + p]), ref, 0.3, 0.03); }
    } else if (stage == 5) {
        const int si = blockIdx.x; if (si >= 96) return; const int tl[12] = {0, 1, 31, 32, 63, 64, 255, 256, 257, 4095, 4096, 8191};
        const int b = si & 1, h = dh(si * 31 + 5) & 31, t = (si < 24) ? tl[si >> 1] : (int)(dh(si * 17 + 3) % SEQ), d = dh(si * 13 + 1) & 127;
        const unsigned char* QN = ws + WS_QN8; const unsigned char* QR = ws + WS_QR8; const unsigned char* K8 = ws + WS_K8; const unsigned char* KR = ws + WS_KR8; const unsigned char* VT = ws + WS_VT8;
        const size_t mt = (size_t)b * SEQ + t; float mx = -1e30f;
        for (int j = tid; j <= t; j += 256) { const size_t mj = (size_t)b * SEQ + j; double s = 0; for (int k = 0; k < 128; ++k) s += fp8d(QN[mt * 4096 + h * 128 + k]) * fp8d(K8[mj * 4096 + h * 128 + k]);
            for (int k = 0; k < 64; ++k) s += fp8d(QR[mt * 2048 + h * 64 + k]) * fp8d(KR[mj * 64 + k]); sh[j] = (float)(s * 0.07216878364870322); mx = fmaxf(mx, sh[j]); }
        red[tid] = mx; __syncthreads(); for (int o = 128; o > 0; o >>= 1) { if (tid < o) red[tid] = fmax(red[tid], red[tid + o]); __syncthreads(); } const double gm = red[0]; __syncthreads();
        double l = 0, ov = 0; for (int j = tid; j <= t; j += 256) { const double pj = exp((double)sh[j] - gm); l += pj; ov += pj * fp8d(VT[(size_t)(b * 4096 + h * 128 + d) * 8192 + vtpos(j)]); }
        red[tid] = l; __syncthreads(); for (int o = 128; o > 0; o >>= 1) { if (tid < o) red[tid] += red[tid + o]; __syncthreads(); } const double L = red[0]; __syncthreads();
        red[tid] = ov; __syncthreads(); for (int o = 128; o > 0; o >>= 1) { if (tid < o) red[tid] += red[tid + o]; __syncthreads(); }
        if (tid == 0) { const double gz = bf2f(PROJ[mt * NP + PC_GATTN + h * 128 + d]); const double ref = red[0] / L * gz / (1.0 + exp(-gz)); chk_put(ew, fp8d((ws + WS_O)[mt * 4096 + h * 128 + d]) / 16.0, ref, 0.05, 0.2); }
    } else if (stage == 6) {
        if (gid < 4096) { const int i = gid & 63, m = dbg_row(i), g = (gid >> 6) & 7, c = g * 1024 + (dh(gid) & 1023); const bf16* yp = (const bf16*)(ws + WS_DBG) + (size_t)i * D_CONV; double s = 0, vc = 0;
            for (int k = 0; k < 1024; ++k) { const double z = bf2f(PROJ[(size_t)m * NP + PC_Z + g * 1024 + k]); const double v = (double)bf2f(yp[g * 1024 + k]) * z / (1.0 + exp(-z)); s += v * v; if (g * 1024 + k == c) vc = v; }
            chk_put(ew, bf2f(((const bf16*)(ws + WS_XBC))[(size_t)m * D_CONV + c]), vc / sqrt(s / 1024 + 1e-6) * a.ssm_norm_w[c], 0.25, 0.01); }
        else if (gid < 8192) { const int n = dh(gid) % DM, k = dh(gid * 3 + 1) % D_SSM; chk_put(ew, bf2f(((const bf16*)(ws + WS_WBS))[(size_t)n * D_SSM + k]), a.w_bs[(size_t)k * DM + n], 1e-3, 0.006); }
        else if (gid < 12288) { const int n = dh(gid) % DM, k = dh(gid * 3 + 1) % DM; chk_put(ew, fp8d((ws + WS_WBA)[(size_t)n * DM + k]) / 64.0, a.w_ba[(size_t)k * DM + n], 1e-3, 0.08); chk_put(ew, bf2f(((const bf16*)(ws + WS_WOUT))[(size_t)n * DM + k]), a.w_out[(size_t)k * DM + n], 1e-3, 0.006); }
    } else if (stage == 7) {
        if (gid < 4096) { const int m = dbg_row(gid & 63), n = dh(gid) % DM; const bf16* y = (const bf16*)(ws + WS_XBC) + (size_t)m * D_CONV; const bf16* w1 = (const bf16*)(ws + WS_WBS) + (size_t)n * D_SSM; double s1 = 0, s2 = 0;
            for (int k = 0; k < D_SSM; ++k) s1 += (double)bf2f(y[k]) * (double)bf2f(w1[k]); const unsigned char* o = ws + WS_O + (size_t)m * DM; const unsigned char* w2 = ws + WS_WBA + (size_t)n * DM; for (int k = 0; k < DM; ++k) s2 += fp8d(o[k]) * fp8d(w2[k]) / 1024.0;
            const double g1 = bf2f(PROJ[(size_t)m * NP + PC_GSSM + n]), g2 = bf2f(PROJ[(size_t)m * NP + PC_GATT2 + n]);
            chk_put(ew, bf2f(((const bf16*)(ws + WS_MERGED))[(size_t)m * DM + n]), s1 / (1.0 + exp(-g1)) + s2 / (1.0 + exp(-g2)), 0.25, 0.012); }
    } else if (stage == 8) {
        if (gid < 4096) { const int m = dbg_row(gid & 63), n = dh(gid) % DM; const bf16* y = (const bf16*)(ws + WS_MERGED) + (size_t)m * DM; const bf16* w = (const bf16*)(ws + WS_WOUT) + (size_t)n * DM; double s = 0; for (int k = 0; k < DM; ++k) s += (double)bf2f(y[k]) * (double)bf2f(w[k]);
            chk_put(ew, bf2f(((const bf16*)(ws + WS_H16))[(size_t)m * DM + n]), s + a.x[(size_t)m * DM + n], 0.25, 0.01); }
    }
}
__global__ void dbg_scan8(Args a, const unsigned char* p, size_t n, int slot) {
    unsigned* ew = (unsigned*)(a.ws + WS_CTL) + CW_CHK + slot; bool bad = false;
    for (size_t i = ((size_t)blockIdx.x * blockDim.x + threadIdx.x) * 4; i < n; i += (size_t)gridDim.x * blockDim.x * 4) { const unsigned w = *(const unsigned*)(p + i); if ((((w & 0x7F7F7F7Fu) + 0x01010101u) & 0x80808080u) != 0u) bad = true; }
    if (bad) atomicMax(ew, __float_as_uint(1e30f));
}
__device__ __forceinline__ unsigned char dbg_i2f8(int v) { const int a = v < 0 ? -v : v; const unsigned char t[5] = {0x00, 0x38, 0x40, 0x44, 0x48}; return (unsigned char)(t[a] | (v < 0 ? 0x80 : 0)); }
__device__ __forceinline__ int dbg_Aik(int i, int k) { return ((i * 7 + k * 3 + (k >> 5)) % 5) - 2; }
__device__ __forceinline__ int dbg_Bkj(int k, int j) { return ((k * 5 + j * 11 + (k >> 4)) % 7) - 3; }
__global__ void dbg_mfma(Args a) {
    typedef int v8i_t __attribute__((ext_vector_type(8))); typedef float f4 __attribute__((ext_vector_type(4)));
    unsigned* ew = (unsigned*)(a.ws + WS_CTL) + CW_CHK + 12;
    const int l = threadIdx.x, r16 = l & 15, q = l >> 4;
    v8i_t fa, fb;
    for (int w = 0; w < 8; ++w) { unsigned wa = 0, wb = 0; for (int e = 0; e < 4; ++e) { const int k = 32 * q + 4 * w + e; wa |= (unsigned)dbg_i2f8(dbg_Aik(r16, k)) << (8 * e); wb |= (unsigned)dbg_i2f8(dbg_Bkj(k, r16)) << (8 * e); } fa[w] = (int)wa; fb[w] = (int)wb; }
    int one = 0x7F7F7F7F, s6 = 0x79797979; asm volatile("" : "+v"(one), "+v"(s6));
    f4 d1 = {0.f, 0.f, 0.f, 0.f}, d2 = {0.f, 0.f, 0.f, 0.f}, d3 = {0.f, 0.f, 0.f, 0.f};
    asm volatile("v_mfma_scale_f32_16x16x128_f8f6f4 %0, %1, %2, %0, %3, %4 op_sel_hi:[0,0,0]" : "+v"(d1) : "v"(fa), "v"(fb), "v"(one), "v"(one));
    asm volatile("v_mfma_scale_f32_16x16x128_f8f6f4 %0, %1, %2, %0, %3, %4 op_sel_hi:[0,0,0]" : "+v"(d2) : "v"(fa), "v"(fb), "v"(s6), "v"(s6));
    asm volatile("s_nop 15\n\ts_nop 15" ::: "memory");
    d3 = __builtin_amdgcn_mfma_scale_f32_16x16x128_f8f6f4(fa, fb, d3, 0, 0, 0, s6, 0, s6);
    int bits = 0;
    for (int r = 0; r < 4; ++r) { const int i = 4 * q + r, j = r16; int ref = 0; for (int k = 0; k < 128; ++k) ref += dbg_Aik(i, k) * dbg_Bkj(k, j);
        if (d1[r] != (float)ref) bits |= 1; if (d2[r] != (float)ref / 4096.0f) bits |= 2; if (d3[r] != (float)ref / 4096.0f) bits |= 4; }
    if (bits) atomicMax(ew, __float_as_uint((float)(1 << bits)));
}
__global__ void dbg_final(Args a) {
    const unsigned* ew = (const unsigned*)(a.ws + WS_CTL) + CW_CHK; const unsigned* ctl = (const unsigned*)(a.ws + WS_CTL);
    int bad = -1, cls = 0;
    const int order[12] = {12, 9, 11, 0, 1, 2, 3, 4, 5, 6, 7, 8};
    for (int si = 0; si < 12; ++si) { const int s = order[si]; const float e = __uint_as_float(ew[s]); const float tol = 1.0f; if (e > tol) { bad = s; float r = e / tol; cls = 0; while (r >= 2.f && cls < 7) { r *= 0.5f; ++cls; } break; } }
    if (bad < 0 && (ctl[CW_TMO] != 0u || ctl[CW_BAR + XB_TMO] != 0u)) { bad = 10; cls = 0; }
    if (bad < 0) return;
    const size_t n = (size_t)M * DM; for (size_t i = (size_t)blockIdx.x * blockDim.x + threadIdx.x; i < n; i += (size_t)gridDim.x * blockDim.x) a.out[i] = (i == 0) ? (float)((10 + 8 * bad + cls) * 100) : 0.f;
}
#ifndef DBG_LAST
#define DBG_LAST 9
#endif
static void dbg_run(Args a, int grid, hipStream_t stream) {
    for (int p = 0; p < NPHASE; ++p) {
        if (p == 6) hipLaunchKernelGGL(dbg_save_rows, dim3(DBG_NROW), dim3(256), 0, stream, a);
        if (p <= DBG_LAST) { a.ph_lo = p; a.ph_hi = p + 1; hipLaunchKernelGGL(mk_fwd, dim3(grid), dim3(NWAVES * 64), LDS_BYTES, stream, a); }
        if (p <= DBG_LAST && p < 9) hipLaunchKernelGGL(dbg_chk, dim3(96), dim3(256), 0, stream, a, p);
        if (p == 5) hipLaunchKernelGGL(dbg_scan8, dim3(1024), dim3(256), 0, stream, a, (const unsigned char*)a.ws + WS_O, (size_t)M * DM, 9);
        if (p == 6) hipLaunchKernelGGL(dbg_scan8, dim3(1024), dim3(256), 0, stream, a, (const unsigned char*)a.ws + WS_WBA, (size_t)DM * DM, 11);
        if (p == 0) hipLaunchKernelGGL(dbg_mfma, dim3(1), dim3(64), 0, stream, a);
    }
    hipLaunchKernelGGL(dbg_final, dim3(1024), dim3(256), 0, stream, a);
}
#endif

extern "C" void kernel_launch(void* const* d_in, const int* in_sizes, int n_in, void* d_out, int out_size, void* d_ws, size_t ws_size, hipStream_t stream) {
    static int grid = 0;
    if (grid == 0) {
        if (n_in != 17 || in_sizes[0] != M * DM || out_size != M * DM || ws_size < WS_TOTAL) { fprintf(stderr, "kernel_launch: unexpected shapes (n_in %d, ws %zu)\n", n_in, ws_size); grid = -1; return; }
        int dev = 0, cus = 0, per_cu = 0;
        if (hipGetDevice(&dev) != hipSuccess || hipDeviceGetAttribute(&cus, hipDeviceAttributeMultiprocessorCount, dev) != hipSuccess) { grid = -1; return; }
        if (hipFuncSetAttribute((const void*)mk_fwd, hipFuncAttributeMaxDynamicSharedMemorySize, LDS_BYTES) != hipSuccess) { fprintf(stderr, "kernel_launch: hipFuncSetAttribute failed\n"); grid = -1; return; }
        if (hipOccupancyMaxActiveBlocksPerMultiprocessor(&per_cu, (const void*)mk_fwd, NWAVES * 64, LDS_BYTES) != hipSuccess || per_cu < 1) { fprintf(stderr, "kernel_launch: occupancy query says %d\n", per_cu); }
        (void)hipGetLastError();
        grid = cus;
    }
    if (grid < 0) return;
    (void)hipMemsetAsync((char*)d_ws + WS_CTL, 0, CTL_ZERO_BYTES, stream);
    Args a{};
    a.x = (const float*)d_in[0]; a.norm_in_w = (const float*)d_in[1]; a.w_in = (const float*)d_in[2]; a.conv_w = (const float*)d_in[3]; a.conv_b = (const float*)d_in[4];
    a.dt_bias = (const float*)d_in[5]; a.a_log = (const float*)d_in[6]; a.d_skip = (const float*)d_in[7]; a.ssm_norm_w = (const float*)d_in[8]; a.q_norm_w = (const float*)d_in[9];
    a.w_uq = (const float*)d_in[10]; a.kv_norm_w = (const float*)d_in[11]; a.w_ukv = (const float*)d_in[12]; a.w_bs = (const float*)d_in[13]; a.w_ba = (const float*)d_in[14];
    a.w_out = (const float*)d_in[15]; a.norm_final_w = (const float*)d_in[16];
    a.out = (float*)d_out; a.ws = (unsigned char*)d_ws;
#if MK_DEBUG
    dbg_run(a, grid, stream);
#else
    a.ph_lo = 0; a.ph_hi = NPHASE;
    hipLaunchKernelGGL(mk_fwd, dim3(grid), dim3(NWAVES * 64), LDS_BYTES, stream, a);
#endif
}
```

```cpp
#include <hip/hip_runtime.h>
#include <cstdio>
#include <cstdint>

#ifndef MK_DEBUG
#define MK_DEBUG 0
#endif

namespace pg8 {
#define PG8_LAS __attribute__((address_space(3)))
typedef unsigned short bf16_t;
typedef short bf16x8 __attribute__((ext_vector_type(8)));
typedef float f32x4 __attribute__((ext_vector_type(4)));
typedef unsigned u32x4 __attribute__((ext_vector_type(4)));
typedef int v4i_t __attribute__((ext_vector_type(4)));
constexpr int BM = 256, BK = 64, HALF = 128, HTB = HALF * BK * 2, STAGE_BYTES = 8 * HTB, NXCD = 8, WGM = 8;

__host__ __device__ __forceinline__ int lds_byte(int r, int c) { const int st = (r >> 4) * 2 + (c >> 5), rr = r & 15, cc = c & 31, ob = rr * 64 + cc * 2; return st * 1024 + (ob ^ (((ob >> 9) & 1) << 5)); }
__host__ __device__ __forceinline__ void stage_rc(int b, int& R, int& C) { const int st = b / 1024, sb = b % 1024, swz = sb ^ (((sb >> 9) & 1) << 5); R = (st >> 1) * 16 + swz / 64; C = (st & 1) * 32 + (swz % 64) / 2; }
__host__ __device__ __forceinline__ int perm32(int rho) { const int n = rho >> 4, i = rho & 15; return 8 * (i >> 2) + 4 * n + (i & 3); }

struct Unit { int pm, pn; };
struct Gemm { const bf16_t* A; const bf16_t* Bt; int M, N, K, lda, ldb; int sX = 0x7F7F7F7F, sW = 0x7F7F7F7F; };

struct StaticOrder {
    int nM, nN, nwg, G, c;
    __host__ __device__ void init(int M, int N, int G_, int c_) { nM = M / BM; nN = N / BM; nwg = nM * nN; G = G_; c = c_; }
    __host__ __device__ bool next(int i, Unit& u) const {
        const long L = (long)i * G + c; if (L >= nwg) return false;
        int wgid = (int)L; { const int q = nwg / NXCD, r = nwg % NXCD, xcd = wgid % NXCD, off = wgid / NXCD; wgid = (xcd < r ? xcd * (q + 1) : r * (q + 1) + (xcd - r) * q) + off; }
        const int nig = WGM * nN, gid = wgid / nig, fm = gid * WGM, gsz = (nM - fm) < WGM ? (nM - fm) : WGM;
        u.pm = fm + ((wgid % nig) % gsz); u.pn = (wgid % nig) / gsz; return true;
    }
    __device__ __forceinline__ void a_ready(const Unit&) const {}
    __device__ __forceinline__ void done(const Unit&) const {}
};

struct SyncedOrder : StaticOrder {
    unsigned* cnt; int per_xcd; int nfull;
    mutable int k;
    __device__ __forceinline__ void a_ready(const Unit&) const {
        const int kk = k; k = kk + 1;
        if (kk == 0 || kk >= nfull) return;
        if (threadIdx.x == 0) {
            __hip_atomic_fetch_add(cnt, 1u, __ATOMIC_RELAXED, __HIP_MEMORY_SCOPE_AGENT);
            const unsigned want = (unsigned)(per_xcd * kk); unsigned sp = 0;
            while (__hip_atomic_load(cnt, __ATOMIC_RELAXED, __HIP_MEMORY_SCOPE_AGENT) < want) { __builtin_amdgcn_s_sleep(1); if (++sp > (1u << 14)) break; }
        }
        asm volatile("" ::: "memory"); __builtin_amdgcn_s_barrier(); asm volatile("" ::: "memory");
    }
};

typedef float f32x2c_t __attribute__((ext_vector_type(2))); typedef __bf16 bf16x2c_t __attribute__((ext_vector_type(2)));
__device__ __forceinline__ unsigned cvt_pk_bf16(float lo, float hi) { f32x2c_t v = {lo, hi}; bf16x2c_t b = __builtin_convertvector(v, bf16x2c_t); return __builtin_bit_cast(unsigned, b); }
__device__ __forceinline__ float bf_lo(unsigned w) { return __uint_as_float(w << 16); }
__device__ __forceinline__ float bf_hi(unsigned w) { return __uint_as_float(w & 0xffff0000u); }
__device__ __forceinline__ float sigmoidf_(float x) { return __builtin_amdgcn_rcpf(1.0f + __expf(-x)); }

#define EPI_LOOP_BEGIN  _Pragma("unroll") for (int ai = 0; ai < 2; ++ai) _Pragma("unroll") for (int m = 0; m < 4; ++m) { const int row = row0 + ai * HALF + m * 16; _Pragma("unroll") for (int bj = 0; bj < 2; ++bj) { \
        f32x4 v0 = acc[ai][bj][m][0], v1 = acc[ai][bj][m][1]; const int col = col0 + bj * HALF;
#define EPI_LOOP_END } }
#define EPI_PACK(w, v0, v1) u32x4 w; w.x = cvt_pk_bf16(v0[0], v0[1]); w.y = cvt_pk_bf16(v0[2], v0[3]); w.z = cvt_pk_bf16(v1[0], v1[1]); w.w = cvt_pk_bf16(v1[2], v1[3]);

struct EpiProj {
    static constexpr bool PERM = true;
    bf16_t* O; int ldc; float* dt32; int dt_pn;
    __device__ __forceinline__ void operator()(const f32x4 (&acc)[2][2][4][2], const Unit& u, int wr, int wc, int fr, int fq) const {
        const int row0 = u.pm * BM + wr * 64 + fr, col0 = u.pn * BM + wc * 32 + 8 * fq; const bool isdt = (u.pn == dt_pn);
        EPI_LOOP_BEGIN
            if (!isdt) { EPI_PACK(w, v0, v1); *(u32x4*)(O + (size_t)row * ldc + col) = w; }
            else if (bj == 0) { float* d = dt32 + (size_t)row * 128 + wc * 32 + 8 * fq; *(f32x4*)d = v0; *(f32x4*)(d + 4) = v1; }
        EPI_LOOP_END
    }
};
struct EpiQ {
    static constexpr bool PERM = true;
    bf16_t* QN; bf16_t* QR; const float* rstd; const float* COS; const float* SIN;
    __device__ __forceinline__ void operator()(const f32x4 (&acc)[2][2][4][2], const Unit& u, int wr, int wc, int fr, int fq) const {
        const int row0 = u.pm * BM + wr * 64 + fr, col0 = u.pn * BM + wc * 32 + 8 * fq; const bool rope = (u.pn >= 16);
        EPI_LOOP_BEGIN
            const float rs = rstd[row]; v0 = v0 * rs; v1 = v1 * rs;
            if (!rope) { EPI_PACK(w, v0, v1); *(u32x4*)(QN + (size_t)row * 4096 + col) = w; }
            else { const int cr = col - 4096, i0 = (cr & 63) >> 1, pos = row & 8191;
                const f32x4 c = *(const f32x4*)(COS + pos * 32 + i0), s = *(const f32x4*)(SIN + pos * 32 + i0);
                f32x4 o0, o1;
                o0[0] = v0[0] * c[0] - v0[1] * s[0]; o0[1] = v0[1] * c[0] + v0[0] * s[0]; o0[2] = v0[2] * c[1] - v0[3] * s[1]; o0[3] = v0[3] * c[1] + v0[2] * s[1];
                o1[0] = v1[0] * c[2] - v1[1] * s[2]; o1[1] = v1[1] * c[2] + v1[0] * s[2]; o1[2] = v1[2] * c[3] - v1[3] * s[3]; o1[3] = v1[3] * c[3] + v1[2] * s[3];
                EPI_PACK(w, o0, o1); *(u32x4*)(QR + (size_t)row * 2048 + cr) = w; }
        EPI_LOOP_END
    }
};
__device__ __forceinline__ unsigned pk4_fp8(float a, float b, float c, float d) { int w = __builtin_amdgcn_cvt_pk_fp8_f32(a, b, 0, false); w = __builtin_amdgcn_cvt_pk_fp8_f32(c, d, w, true); return (unsigned)w; }
typedef unsigned u32x2 __attribute__((ext_vector_type(2)));
struct EpiProj8 {
    static constexpr bool PERM = true;
    bf16_t* O; int ldc; unsigned char* cq8; unsigned char* kv8; int cq_pn, kv_pn;
    __device__ __forceinline__ void operator()(const f32x4 (&acc)[2][2][4][2], const Unit& u, int wr, int wc, int fr, int fq) const {
        const int row0 = u.pm * BM + wr * 64 + fr, col0 = u.pn * BM + wc * 32 + 8 * fq; const bool iscq = (u.pn >= cq_pn && u.pn < cq_pn + 4), iskv = (u.pn == kv_pn || u.pn == kv_pn + 1);
        EPI_LOOP_BEGIN
            EPI_PACK(w, v0, v1); *(u32x4*)(O + (size_t)row * ldc + col) = w;
            if (iscq || iskv) { u32x2 w8; w8.x = pk4_fp8(v0[0], v0[1], v0[2], v0[3]); w8.y = pk4_fp8(v1[0], v1[1], v1[2], v1[3]);
                if (iscq) *(u32x2*)(cq8 + (size_t)row * 1024 + (col - cq_pn * BM)) = w8; else *(u32x2*)(kv8 + (size_t)row * 512 + (col - kv_pn * BM)) = w8; }
        EPI_LOOP_END
    }
};
struct EpiQ8 {
    static constexpr bool PERM = true;
    unsigned char* QN; unsigned char* QR; const float* rstd; const float* COS; const float* SIN;
    __device__ __forceinline__ void operator()(const f32x4 (&acc)[2][2][4][2], const Unit& u, int wr, int wc, int fr, int fq) const {
        const int row0 = u.pm * BM + wr * 64 + fr, col0 = u.pn * BM + wc * 32 + 8 * fq; const bool rope = (u.pn >= 16);
        const int cr0 = col0 - 4096, i0 = (cr0 & 63) >> 1;
#pragma unroll
        for (int am = 0; am < 4; ++am) {
            const int ai = am >> 1;
            float rs[2]; f32x4 cq[2], sq[2];
#pragma unroll
            for (int mm = 0; mm < 2; ++mm) { const int row = row0 + ai * HALF + (2 * (am & 1) + mm) * 16; rs[mm] = rstd[row];
                if (rope) { const int pos = row & 8191; cq[mm] = *(const f32x4*)(COS + pos * 32 + i0); sq[mm] = *(const f32x4*)(SIN + pos * 32 + i0); } }
            asm volatile("" : "+v"(rs[0]), "+v"(rs[1]));
            if (rope) asm volatile("" : "+v"(cq[0]), "+v"(cq[1]), "+v"(sq[0]), "+v"(sq[1]));
#pragma unroll
            for (int mm = 0; mm < 2; ++mm)
#pragma unroll
                for (int bj = 0; bj < 2; ++bj) { const int m = 2 * (am & 1) + mm, row = row0 + ai * HALF + m * 16, col = col0 + bj * HALF;
                    f32x4 v0 = acc[ai][bj][m][0] * rs[mm], v1 = acc[ai][bj][m][1] * rs[mm];
                    if (!rope) { u32x2 w; w.x = pk4_fp8(v0[0], v0[1], v0[2], v0[3]); w.y = pk4_fp8(v1[0], v1[1], v1[2], v1[3]); *(u32x2*)(QN + (size_t)row * 4096 + col) = w; }
                    else { const int cr = col - 4096; const f32x4 c = cq[mm], s_ = sq[mm];
                        f32x4 o0, o1;
                        o0[0] = v0[0] * c[0] - v0[1] * s_[0]; o0[1] = v0[1] * c[0] + v0[0] * s_[0]; o0[2] = v0[2] * c[1] - v0[3] * s_[1]; o0[3] = v0[3] * c[1] + v0[2] * s_[1];
                        o1[0] = v1[0] * c[2] - v1[1] * s_[2]; o1[1] = v1[1] * c[2] + v1[0] * s_[2]; o1[2] = v1[2] * c[3] - v1[3] * s_[3]; o1[3] = v1[3] * c[3] + v1[2] * s_[3];
                        u32x2 w; w.x = pk4_fp8(o0[0], o0[1], o0[2], o0[3]); w.y = pk4_fp8(o1[0], o1[1], o1[2], o1[3]); *(u32x2*)(QR + (size_t)row * 2048 + cr) = w; } }
        }
    }
};
struct EpiK8 {
    static constexpr bool PERM = true;
    unsigned char* K8; const float* rstd;
    __device__ __forceinline__ void operator()(const f32x4 (&acc)[2][2][4][2], const Unit& u, int wr, int wc, int fr, int fq) const {
        const int row0 = u.pm * BM + wr * 64 + fr, col0 = u.pn * BM + wc * 32 + 8 * fq;
        float rs[2][4];
#pragma unroll
        for (int ai = 0; ai < 2; ++ai)
#pragma unroll
            for (int m = 0; m < 4; ++m) rs[ai][m] = rstd[row0 + ai * HALF + m * 16];
        asm volatile("" : "+v"(rs[0][0]), "+v"(rs[0][1]), "+v"(rs[0][2]), "+v"(rs[0][3]), "+v"(rs[1][0]), "+v"(rs[1][1]), "+v"(rs[1][2]), "+v"(rs[1][3]));
        EPI_LOOP_BEGIN
            v0 = v0 * rs[ai][m]; v1 = v1 * rs[ai][m];
            u32x2 w; w.x = pk4_fp8(v0[0], v0[1], v0[2], v0[3]); w.y = pk4_fp8(v1[0], v1[1], v1[2], v1[3]); *(u32x2*)(K8 + (size_t)row * 4096 + col) = w;
        EPI_LOOP_END
    }
};
struct EpiVT8 {
    static constexpr bool PERM = true;
    unsigned char* VT; const float* rstd;
    __device__ __forceinline__ void operator()(const f32x4 (&acc)[2][2][4][2], const Unit& u, int wr, int wc, int fr, int fq) const {
        const int row0 = u.pm * BM + wr * 64 + fr, col0 = u.pn * BM + wc * 32 + 8 * fq;
        f32x4 r0[2], r1[2];
#pragma unroll
        for (int bj = 0; bj < 2; ++bj) { r0[bj] = *(const f32x4*)(rstd + col0 + bj * HALF); r1[bj] = *(const f32x4*)(rstd + col0 + bj * HALF + 4); }
        EPI_LOOP_BEGIN
            v0 = v0 * r0[bj]; v1 = v1 * r1[bj];
            const int bb = col >> 13, t = col & 8191, k64 = t & 63;
            unsigned char* p = VT + ((size_t)(bb * 4096 + row) * 8192) + (t & ~63) + 16 * (k64 >> 5) + 4 * ((k64 >> 3) & 3);
            *(unsigned*)p = pk4_fp8(v0[0], v0[1], v0[2], v0[3]); *(unsigned*)(p + 32) = pk4_fp8(v1[0], v1[1], v1[2], v1[3]);
        EPI_LOOP_END
    }
};
struct EpiKV {
    static constexpr bool PERM = true;
    bf16_t* KV; const float* rstd;
    __device__ __forceinline__ void operator()(const f32x4 (&acc)[2][2][4][2], const Unit& u, int wr, int wc, int fr, int fq) const {
        const int row0 = u.pm * BM + wr * 64 + fr, col0 = u.pn * BM + wc * 32 + 8 * fq;
        EPI_LOOP_BEGIN
            const float rs = rstd[row]; v0 = v0 * rs; v1 = v1 * rs;
            EPI_PACK(w, v0, v1); *(u32x4*)(KV + (size_t)row * 8192 + col) = w;
        EPI_LOOP_END
    }
};
template <bool ADD> struct EpiGate {
    static constexpr bool PERM = true;
    bf16_t* T; const bf16_t* gate; int ldg;
    __device__ __forceinline__ void operator()(const f32x4 (&acc)[2][2][4][2], const Unit& u, int wr, int wc, int fr, int fq) const {
        const int row0 = u.pm * BM + wr * 64 + fr, col0 = u.pn * BM + wc * 32 + 8 * fq;
#pragma unroll
        for (int ai = 0; ai < 2; ++ai) {
            u32x4 gq[4][2], tq[4][2];
#pragma unroll
            for (int m = 0; m < 4; ++m)
#pragma unroll
                for (int bj = 0; bj < 2; ++bj) { const size_t row = (size_t)(row0 + ai * HALF + m * 16); const int col = col0 + bj * HALF;
                    gq[m][bj] = *(const u32x4*)(gate + row * ldg + col); if (ADD) tq[m][bj] = *(const u32x4*)(T + row * 4096 + col); }
            asm volatile("" : "+v"(gq[0][0]), "+v"(gq[0][1]), "+v"(gq[1][0]), "+v"(gq[1][1]), "+v"(gq[2][0]), "+v"(gq[2][1]), "+v"(gq[3][0]), "+v"(gq[3][1]));
            if (ADD) asm volatile("" : "+v"(tq[0][0]), "+v"(tq[0][1]), "+v"(tq[1][0]), "+v"(tq[1][1]), "+v"(tq[2][0]), "+v"(tq[2][1]), "+v"(tq[3][0]), "+v"(tq[3][1]));
#pragma unroll
            for (int m = 0; m < 4; ++m)
#pragma unroll
                for (int bj = 0; bj < 2; ++bj) { const size_t row = (size_t)(row0 + ai * HALF + m * 16); const int col = col0 + bj * HALF;
                    f32x4 v0 = acc[ai][bj][m][0], v1 = acc[ai][bj][m][1]; const u32x4 g = gq[m][bj];
                    v0[0] *= sigmoidf_(bf_lo(g.x)); v0[1] *= sigmoidf_(bf_hi(g.x)); v0[2] *= sigmoidf_(bf_lo(g.y)); v0[3] *= sigmoidf_(bf_hi(g.y));
                    v1[0] *= sigmoidf_(bf_lo(g.z)); v1[1] *= sigmoidf_(bf_hi(g.z)); v1[2] *= sigmoidf_(bf_lo(g.w)); v1[3] *= sigmoidf_(bf_hi(g.w));
                    if (ADD) { const u32x4 t = tq[m][bj];
                        v0[0] += bf_lo(t.x); v0[1] += bf_hi(t.x); v0[2] += bf_lo(t.y); v0[3] += bf_hi(t.y); v1[0] += bf_lo(t.z); v1[1] += bf_hi(t.z); v1[2] += bf_lo(t.w); v1[3] += bf_hi(t.w); }
                    EPI_PACK(w, v0, v1); *(u32x4*)(T + row * 4096 + col) = w; }
        }
    }
};
struct EpiOut {
    static constexpr bool PERM = true;
    bf16_t* out; const float* x;
    __device__ __forceinline__ void operator()(const f32x4 (&acc)[2][2][4][2], const Unit& u, int wr, int wc, int fr, int fq) const {
        const int row0 = u.pm * BM + wr * 64 + fr, col0 = u.pn * BM + wc * 32 + 8 * fq;
#pragma unroll
        for (int ai = 0; ai < 2; ++ai) {
            f32x4 xa[4][2], xb[4][2];
#pragma unroll
            for (int m = 0; m < 4; ++m)
#pragma unroll
                for (int bj = 0; bj < 2; ++bj) { const size_t o = (size_t)(row0 + ai * HALF + m * 16) * 4096 + col0 + bj * HALF; xa[m][bj] = *(const f32x4*)(x + o); xb[m][bj] = *(const f32x4*)(x + o + 4); }
            asm volatile("" : "+v"(xa[0][0]), "+v"(xa[0][1]), "+v"(xa[1][0]), "+v"(xa[1][1]), "+v"(xa[2][0]), "+v"(xa[2][1]), "+v"(xa[3][0]), "+v"(xa[3][1]));
            asm volatile("" : "+v"(xb[0][0]), "+v"(xb[0][1]), "+v"(xb[1][0]), "+v"(xb[1][1]), "+v"(xb[2][0]), "+v"(xb[2][1]), "+v"(xb[3][0]), "+v"(xb[3][1]));
#pragma unroll
            for (int m = 0; m < 4; ++m)
#pragma unroll
                for (int bj = 0; bj < 2; ++bj) { const size_t o = (size_t)(row0 + ai * HALF + m * 16) * 4096 + col0 + bj * HALF;
                    f32x4 v0 = acc[ai][bj][m][0] + xa[m][bj], v1 = acc[ai][bj][m][1] + xb[m][bj];
                    EPI_PACK(w, v0, v1); *(u32x4*)(out + o) = w; }
        }
    }
};

template <class Epi, class Sched, int PROBE = 0, bool SP2 = true, bool FP8 = false>
__device__ __forceinline__ void gemm_phase(PG8_LAS unsigned char* lds, const Gemm g, const Sched& S, const Epi& E) {
    const int tid = threadIdx.x, wid = __builtin_amdgcn_readfirstlane(tid >> 6), lane = tid & 63, wr = wid >> 2, wc = wid & 3, fr = lane & 15, fq = lane >> 4;
    const int K = g.K, nt = K / BK;
    unsigned voffA[2], voffB[2];
#pragma unroll
    for (int i = 0; i < 2; ++i) { int R, C; stage_rc(tid * 16 + i * 8192, R, C); const int Rb = Epi::PERM ? ((R & ~31) + perm32(R & 31)) : R;
        voffA[i] = (unsigned)(R * g.lda + C) * 2u; voffB[i] = (unsigned)(Rb * g.ldb + C) * 2u; }
    const size_t kstep = (size_t)(BK * 2);
    const size_t hstepA = (size_t)HALF * g.lda * 2, hstepB = (size_t)HALF * g.ldb * 2;
    const size_t tstepA = 2 * hstepA, tstepB = 2 * hstepB;
    const unsigned ldsw = (unsigned)wid * 1024u;
    const int aoff = lds_byte(wr * 64 + fr, fq * 8), boff = lds_byte(wc * 32 + fr, fq * 8);
#define PG8_SA(b, h) (((b) * 2 + (h)) * HTB)
#define PG8_SB(b, h) ((4 + (b) * 2 + (h)) * HTB)
#define PG8_STAGE(bufoff, gbase, voff) do { if (PROBE != 1) _Pragma("unroll") for (int _i = 0; _i < 2; ++_i) \
        __builtin_amdgcn_global_load_lds((const unsigned*)((const char*)(PROBE == 3 ? (const char*)g.A : (const char*)(gbase)) + (voff)[_i]), (PG8_LAS unsigned*)(lds + (bufoff) + ldsw + _i * 8192), 16, 0, 0); } while (0)
#define PG8_CAT(x, y) __builtin_shufflevector(__builtin_bit_cast(v4i_t, x), __builtin_bit_cast(v4i_t, y), 0, 1, 2, 3, 4, 5, 6, 7)
#define PG8_LDA(dst, b, h) do { _Pragma("unroll") for (int m = 0; m < 4; ++m) { \
        if constexpr (FP8) { A8[m].lo = *(const PG8_LAS v4i_t*)(lds + PG8_SA(b, h) + aoff + m * 2048); A8[m].hi = *(const PG8_LAS v4i_t*)(lds + PG8_SA(b, h) + aoff + m * 2048 + 1024); } \
        else { _Pragma("unroll") for (int k = 0; k < 2; ++k) dst[m][k] = *(const PG8_LAS bf16x8*)(lds + PG8_SA(b, h) + aoff + m * 2048 + k * 1024); } } } while (0)
#define PG8_LDB(dst, b, h) do { _Pragma("unroll") for (int n = 0; n < 2; ++n) { \
        if constexpr (FP8) { dst##8[n].lo = *(const PG8_LAS v4i_t*)(lds + PG8_SB(b, h) + boff + n * 2048); dst##8[n].hi = *(const PG8_LAS v4i_t*)(lds + PG8_SB(b, h) + boff + n * 2048 + 1024); } \
        else { _Pragma("unroll") for (int k = 0; k < 2; ++k) dst[n][k] = *(const PG8_LAS bf16x8*)(lds + PG8_SB(b, h) + boff + n * 2048 + k * 1024); } } } while (0)
#define PG8_MMA(ai, bj, At, Bt) do { __builtin_amdgcn_s_setprio(1); \
        if constexpr (FP8) { _Pragma("unroll") for (int m = 0; m < 4; ++m) _Pragma("unroll") for (int n = 0; n < 2; ++n) \
            asm volatile("v_mfma_scale_f32_16x16x128_f8f6f4 %0, %1, %2, %0, %3, %4 op_sel_hi:[0,0,0]" : "+v"(acc[ai][bj][m][n]) : "v"(Bt##8[n]), "v"(A8[m]), "v"(sWv), "v"(sXv)); } \
        else { _Pragma("unroll") for (int m = 0; m < 4; ++m) _Pragma("unroll") for (int n = 0; n < 2; ++n) _Pragma("unroll") for (int k = 0; k < 2; ++k) \
        acc[ai][bj][m][n] = __builtin_amdgcn_mfma_f32_16x16x32_bf16(Bt[n][k], At[m][k], acc[ai][bj][m][n], 0, 0, 0); } __builtin_amdgcn_s_setprio(0); } while (0)
#define PG8_WAIT_V(n) asm volatile("s_waitcnt vmcnt(" #n ")" ::: "memory")
#define PG8_WAIT_L(n) asm volatile("s_waitcnt lgkmcnt(" #n ")" ::: "memory")
#define PG8_BAR __builtin_amdgcn_s_barrier()
#define PG8_SCHED __builtin_amdgcn_sched_barrier(0)
    Unit cur, nxt; int ui = 0;
    if (!S.next(0, cur)) return;
    f32x4 acc[2][2][4][2];
#pragma unroll
    for (int a = 0; a < 2; ++a)
#pragma unroll
        for (int b = 0; b < 2; ++b)
#pragma unroll
            for (int m = 0; m < 4; ++m)
#pragma unroll
                for (int n = 0; n < 2; ++n) acc[a][b][m][n] = (f32x4){0.f, 0.f, 0.f, 0.f};
    bf16x8 At[4][2], B0[2][2], B1[2][2];
    typedef int v8i_t __attribute__((ext_vector_type(8))); v8i_t A8[4], B08[2], B18[2];
    static_assert(!FP8 || SP2, "the fp8 form exists for the SP2 loop only");
    const int sWv = g.sW, sXv = g.sX;
    const char* cA = (const char*)g.A + (size_t)cur.pm * tstepA; const char* cB = (const char*)g.Bt + (size_t)cur.pn * tstepB;
    S.a_ready(cur);
    if constexpr (SP2) {
    PG8_STAGE(PG8_SB(0, 0), cB, voffB); PG8_STAGE(PG8_SB(0, 1), cB + hstepB, voffB); PG8_STAGE(PG8_SA(0, 0), cA, voffA); PG8_STAGE(PG8_SA(0, 1), cA + hstepA, voffA);
    if (wr == 1) PG8_BAR;
    PG8_WAIT_V(2); PG8_BAR;
    PG8_STAGE(PG8_SB(1, 0), cB + kstep, voffB); PG8_STAGE(PG8_SA(1, 0), cA + kstep, voffA); PG8_STAGE(PG8_SB(1, 1), cB + hstepB + kstep, voffB);
    PG8_WAIT_V(6); PG8_BAR;
    } else {
    PG8_STAGE(PG8_SB(0, 0), cB, voffB); PG8_STAGE(PG8_SA(0, 0), cA, voffA); PG8_STAGE(PG8_SB(0, 1), cB + hstepB, voffB); PG8_STAGE(PG8_SA(0, 1), cA + hstepA, voffA);
    if (wr == 1) PG8_BAR;
    PG8_WAIT_V(4); PG8_BAR;
    PG8_STAGE(PG8_SB(1, 0), cB + kstep, voffB); PG8_STAGE(PG8_SA(1, 0), cA + kstep, voffA); PG8_STAGE(PG8_SB(1, 1), cB + hstepB + kstep, voffB);
    PG8_WAIT_V(6); PG8_BAR;
    }
    for (;;) {
        const bool has_next = S.next(ui + 1, nxt);
        const char* nA = has_next ? (const char*)g.A + (size_t)nxt.pm * tstepA : cA; const char* nB = has_next ? (const char*)g.Bt + (size_t)nxt.pn * tstepB : cB;
        asm volatile(".p2align 6");
        for (int t = 0; t < nt; t += 2) {
            const bool last = (t == nt - 2);
            const char* a1 = cA + (size_t)(t + 1) * kstep;
            const char* a2 = last ? nA : cA + (size_t)(t + 2) * kstep; const char* b2 = last ? nB : cB + (size_t)(t + 2) * kstep;
            const char* a3 = a2 + kstep; const char* b3 = b2 + kstep;
            if (last && has_next) S.a_ready(nxt);
            if constexpr (SP2) {
            PG8_LDB(B0, 0, 0); PG8_LDB(B1, 0, 1); PG8_SCHED; PG8_LDA(At, 0, 0); PG8_STAGE(PG8_SA(1, 1), a1 + hstepA, voffA);
            PG8_WAIT_V(8); PG8_WAIT_L(0); PG8_BAR; PG8_MMA(0, 0, At, B0); PG8_MMA(0, 1, At, B1); PG8_BAR; PG8_SCHED;
            PG8_LDA(At, 0, 1); PG8_STAGE(PG8_SB(0, 0), b2, voffB); PG8_STAGE(PG8_SB(0, 1), b2 + hstepB, voffB); PG8_STAGE(PG8_SA(0, 0), a2, voffA);
            PG8_WAIT_V(8); PG8_WAIT_L(0); PG8_BAR; PG8_MMA(1, 0, At, B0); PG8_MMA(1, 1, At, B1); PG8_BAR; PG8_SCHED;
            PG8_LDB(B0, 1, 0); PG8_LDB(B1, 1, 1); PG8_SCHED; PG8_LDA(At, 1, 0); PG8_STAGE(PG8_SA(0, 1), a2 + hstepA, voffA);
            PG8_WAIT_V(8); PG8_WAIT_L(0); PG8_BAR; PG8_MMA(0, 0, At, B0); PG8_MMA(0, 1, At, B1); PG8_BAR; PG8_SCHED;
            PG8_LDA(At, 1, 1); PG8_STAGE(PG8_SB(1, 0), b3, voffB); PG8_STAGE(PG8_SB(1, 1), b3 + hstepB, voffB); PG8_STAGE(PG8_SA(1, 0), a3, voffA);
            PG8_WAIT_V(8); PG8_WAIT_L(0); PG8_BAR; PG8_MMA(1, 0, At, B0); PG8_MMA(1, 1, At, B1); PG8_BAR; PG8_SCHED;
            } else {
            PG8_LDB(B0, 0, 0); PG8_SCHED; PG8_LDA(At, 0, 0); PG8_STAGE(PG8_SA(1, 1), a1 + hstepA, voffA);
            PG8_WAIT_L(8); PG8_BAR; PG8_WAIT_L(0); PG8_MMA(0, 0, At, B0); PG8_BAR; PG8_SCHED;
            PG8_LDB(B1, 0, 1); PG8_STAGE(PG8_SB(0, 0), b2, voffB);
            PG8_BAR; PG8_WAIT_L(0); PG8_MMA(0, 1, At, B1); PG8_BAR;
            PG8_LDA(At, 0, 1); PG8_STAGE(PG8_SA(0, 0), a2, voffA);
            PG8_BAR; PG8_WAIT_L(0); PG8_MMA(1, 0, At, B0); PG8_BAR; PG8_SCHED;
            PG8_STAGE(PG8_SB(0, 1), b2 + hstepB, voffB);
            PG8_WAIT_V(6); PG8_BAR; PG8_MMA(1, 1, At, B1); PG8_BAR;
            PG8_LDB(B0, 1, 0); PG8_SCHED; PG8_LDA(At, 1, 0); PG8_STAGE(PG8_SA(0, 1), a2 + hstepA, voffA);
            PG8_WAIT_L(8); PG8_BAR; PG8_WAIT_L(0); PG8_MMA(0, 0, At, B0); PG8_BAR; PG8_SCHED;
            PG8_LDB(B1, 1, 1); PG8_STAGE(PG8_SB(1, 0), b3, voffB);
            PG8_BAR; PG8_WAIT_L(0); PG8_MMA(0, 1, At, B1); PG8_BAR;
            PG8_LDA(At, 1, 1); PG8_STAGE(PG8_SA(1, 0), a3, voffA);
            PG8_BAR; PG8_WAIT_L(0); PG8_MMA(1, 0, At, B0); PG8_BAR; PG8_SCHED;
            PG8_STAGE(PG8_SB(1, 1), b3 + hstepB, voffB);
            PG8_WAIT_V(6); PG8_BAR; PG8_MMA(1, 1, At, B1); PG8_BAR;
            }
        }
        if constexpr (FP8) asm volatile("s_nop 15\n\ts_nop 15" ::: "memory");
        if (wr == 0) PG8_BAR;
        int fr_ = fr, fq_ = fq; asm volatile("" : "+v"(fr_), "+v"(fq_));
        if (PROBE == 0) E(acc, cur, wr, wc, fr_, fq_); else { float sacc = 0.f; _Pragma("unroll") for (int a_ = 0; a_ < 2; ++a_) _Pragma("unroll") for (int b_ = 0; b_ < 2; ++b_) _Pragma("unroll") for (int m_ = 0; m_ < 4; ++m_) _Pragma("unroll") for (int n_ = 0; n_ < 2; ++n_) sacc += acc[a_][b_][m_][n_][0] + acc[a_][b_][m_][n_][1] + acc[a_][b_][m_][n_][2] + acc[a_][b_][m_][n_][3]; if (sacc == 1.2345e-30f) *(float*)g.A = sacc; }
        S.done(cur);
        if (!has_next) break;
#pragma unroll
        for (int a = 0; a < 2; ++a)
#pragma unroll
            for (int b = 0; b < 2; ++b)
#pragma unroll
                for (int m = 0; m < 4; ++m)
#pragma unroll
                    for (int n = 0; n < 2; ++n) acc[a][b][m][n] = (f32x4){0.f, 0.f, 0.f, 0.f};
        cur = nxt; cA = nA; cB = nB; ++ui;
        if (wr == 1) PG8_BAR;
    }
    PG8_WAIT_V(0);
    PG8_BAR;
#undef PG8_SA
#undef PG8_SB
#undef PG8_STAGE
#undef PG8_LDA
#undef PG8_LDB
#undef PG8_MMA
#undef PG8_CAT
#undef PG8_WAIT_V
#undef PG8_WAIT_L
#undef PG8_BAR
#undef PG8_SCHED
}
}

constexpr int NWAVES = 8;
constexpr int M = 16384, SEQ = 8192, DM = 4096;
constexpr int D_SSM = 8192, D_CONV = 10240, NH_SSM = 128, NG = 8, NSTATE = 128, CHUNK = 128;
constexpr int NHEAD = 32, QK_NOPE = 128, QK_ROPE = 64, VH = 128, Q_LORA = 1024, KV_LORA = 512;
constexpr int D_IN = 32448, NP = 32512;
constexpr int PC_Z = 0, PC_XBC = 8192, PC_GSSM = 18432, PC_A0 = 18432, PC_CQ = 22528, PC_GATTN = 23552, PC_GATT2 = 27648, PC_KV = 31744;
constexpr int N16 = 18688, N8 = 14080, GC_DT = 18432;
constexpr int SC_Z = 0, SC_XBC = 8192, SC_DT = 18432, SC_CQ = 18560, SC_KV = 19584, SC_GATTN = 20160, SC_GSSM = 24256, SC_GATT2 = 28352;
constexpr float EPS = 1e-6f;

constexpr size_t MiB = 1u << 20;
constexpr size_t WS_CTL = 0, CTL_ZERO_BYTES = 1 * MiB;
constexpr size_t WS_RSTDQ = 1 * MiB;
constexpr size_t WS_RSTDKV = WS_RSTDQ + 65536;
constexpr size_t WS_COS = 2 * MiB, WS_SIN = 3 * MiB;
constexpr size_t WS_KROPE = 4 * MiB;
constexpr size_t WS_DT32 = 6 * MiB;
constexpr size_t WS_WUQ = 14 * MiB;
constexpr size_t WS_WUKV = 26 * MiB;
constexpr size_t WS_WIN = 34 * MiB;
constexpr size_t WS_QN = WS_WIN, WS_QR = WS_WIN + 128 * MiB, WS_MERGED = WS_WIN;
constexpr size_t WS_WIN8 = WS_WIN + 148 * MiB;
constexpr size_t WS_CQ8 = WS_WIN + 224 * MiB, WS_KV8 = WS_WIN + 240 * MiB;
constexpr size_t WS_QN8 = WS_WIN, WS_QR8 = WS_WIN + 64 * MiB, WS_K8 = WS_WIN + 96 * MiB, WS_VT8 = WS_WIN + 160 * MiB;
constexpr size_t WS_U = 288 * MiB;
constexpr size_t WS_O = WS_U, WS_H16 = WS_U;
constexpr size_t WS_PROJ = 416 * MiB;
constexpr size_t WS_XBC = 1432 * MiB;
constexpr size_t WS_KV = 1752 * MiB;
constexpr size_t WS_U8 = WS_XBC;
constexpr size_t WS_WBS = WS_KV, WS_WBA = WS_KV + 64 * MiB, WS_WOUT = WS_KV + 96 * MiB;
constexpr size_t WS_END = 2008 * MiB;
constexpr size_t WS_ACS = 2011 * MiB;
constexpr size_t WS_KR8 = 2019 * MiB;
constexpr size_t WS_TOTAL = 2020 * MiB;
static_assert(WS_WIN8 + (size_t)N8 * 4096 <= WS_CQ8 && WS_VT8 + (size_t)64 * MiB <= WS_CQ8 && WS_CQ8 + (size_t)M * 1024 <= WS_KV8 && WS_KV8 + (size_t)M * 512 <= WS_U, "ws map 3");
static_assert(WS_WIN + (size_t)N16 * 4096 * 2 <= WS_WIN8 && WS_WIN8 + (size_t)N8 * 4096 <= WS_U && PC_A0 + N8 == NP && PC_KV + 576 <= NP && WS_PROJ + (size_t)M * NP * 2 <= WS_XBC && WS_XBC + (size_t)M * D_CONV * 2 <= WS_KV && WS_KV + (size_t)M * 8192 * 2 <= WS_END, "ws map");
static_assert(WS_WUQ + (size_t)6144 * 1024 * 2 <= WS_WUKV && WS_WUKV + (size_t)8192 * 512 * 2 <= WS_WIN && WS_DT32 + (size_t)M * 128 * 4 <= WS_WUQ, "ws map 2");

constexpr int CW_TMO = 0, CW_CODE = 1;
constexpr int CW_BAR = 4096;
constexpr int CW_CHK = 16384;
constexpr int CW_XSYNC = 20480;

constexpr int RING_OFF = 0, RING_BYTES = 131072;
constexpr int LDSCTL_OFF = RING_BYTES, MISC_OFF = LDSCTL_OFF + 320;
constexpr int SSD_TAB_OFF = RING_BYTES + 1024;
constexpr int LDS_BYTES = 163840;

#define GAS __attribute__((address_space(1)))
#define LAS __attribute__((address_space(3)))
typedef unsigned short bf16;
typedef unsigned v4u __attribute__((ext_vector_type(4)));
typedef unsigned v2u __attribute__((ext_vector_type(2)));
typedef float f32x4 __attribute__((ext_vector_type(4)));
typedef float f32x16 __attribute__((ext_vector_type(16)));
typedef short bf16x8 __attribute__((ext_vector_type(8)));
typedef short s16x4 __attribute__((ext_vector_type(4)));
typedef GAS unsigned gu32;
#define RLX_AGENT __ATOMIC_RELAXED, __HIP_MEMORY_SCOPE_AGENT
#define LDS_WAIT() asm volatile("s_waitcnt lgkmcnt(0)" ::: "memory")
#define VM_WAIT() asm volatile("s_waitcnt vmcnt(0)" ::: "memory")
__device__ __forceinline__ unsigned f2bf(float f) { unsigned u = __builtin_bit_cast(unsigned, f); return (u + 0x7fffu + ((u >> 16) & 1u)) >> 16; }
__device__ __forceinline__ unsigned pk2(float lo, float hi) { return f2bf(lo) | (f2bf(hi) << 16); }
__device__ __forceinline__ float bflo(unsigned w) { return __uint_as_float(w << 16); }
__device__ __forceinline__ float bfhi(unsigned w) { return __uint_as_float(w & 0xffff0000u); }
__device__ __forceinline__ float bf2f(bf16 b) { return __uint_as_float(((unsigned)b) << 16); }
__device__ __forceinline__ float silu_(float x) { return x * __builtin_amdgcn_rcpf(1.0f + __expf(-x)); }
__device__ __forceinline__ unsigned cvtpk(float lo, float hi) { unsigned r; asm volatile("v_cvt_pk_bf16_f32 %0, %1, %2" : "=v"(r) : "v"(lo), "v"(hi)); return r; }
__device__ __forceinline__ int crow(int r, int hi) { return (r & 3) + 8 * (r >> 2) + 4 * hi; }
__device__ __forceinline__ s16x4 tr_read(unsigned addr) { typedef short v4i16_t __attribute__((ext_vector_type(4))); return __builtin_bit_cast(s16x4, __builtin_amdgcn_ds_read_tr16_b64_v4i16((LAS v4i16_t*)(uintptr_t)addr)); }
__device__ __forceinline__ void glds16(const void* gbase  , unsigned voff, unsigned lds_dst) { unsigned keep;
    asm volatile("s_nop 4\n\ts_mov_b32 %0, m0\n\ts_mov_b32 m0, %3\n\ts_nop 0\n\tglobal_load_lds_dwordx4 %1, %2\n\ts_mov_b32 m0, %0" : "=&s"(keep) : "v"(voff), "s"(gbase), "s"(lds_dst) : "memory"); }

#define XB_TMO      128
#define XB_XCNT(j)  (256  + 64 * (j))
#define XB_XSUB(j)  (1280 + 64 * (j))
#define XB_XGEN(j)  (2304 + 64 * (j))
#define XB_TOP      3328
#define XB_TOPGEN   3392
#define XCD_BAR_WORDS 3456
#define XB_SPIN_CAP (1u << 22)
__device__ __forceinline__ unsigned xb_ld(unsigned* p)              { return __hip_atomic_load(p, __ATOMIC_RELAXED, __HIP_MEMORY_SCOPE_AGENT); }
__device__ __forceinline__ unsigned xb_add(unsigned* p, unsigned v) { return __hip_atomic_fetch_add(p, v, __ATOMIC_RELAXED, __HIP_MEMORY_SCOPE_AGENT); }
__device__ __forceinline__ unsigned xb_xcc_id() { return (unsigned)__builtin_amdgcn_s_getreg((3 << 11) | 20) & 0xFu; }
#define XB_SPIN(cond, bar) do { unsigned _sp = 0; while (cond) { __builtin_amdgcn_s_sleep(1); \
    if ((++_sp & 255u) == 0u) { if (xb_ld(&(bar)[XB_TMO])) break; if (_sp > XB_SPIN_CAP) { atomicAdd(&(bar)[XB_TMO], 1u); break; } } } } while (0)
struct XcdBarrier { unsigned* bar; unsigned x; volatile LAS unsigned* st; };
__device__ __forceinline__ XcdBarrier xcd_barrier_post(unsigned* bar, volatile LAS unsigned* st) {
    XcdBarrier b; b.bar = bar; b.x = xb_xcc_id(); b.st = st;
    if (threadIdx.x == 0) (void)xb_add(&bar[XB_XCNT(b.x)], 1u);
    return b;
}
__device__ __forceinline__ void xcd_barrier_complete(unsigned* bar, unsigned x, unsigned& nloc, unsigned& nx) {
    const unsigned G = gridDim.x * gridDim.y * gridDim.z;
    unsigned sum, cnt, mine, sp = 0u;
    for (;;) {
        sum = 0u; cnt = 0u; mine = 0u;
#pragma unroll
        for (unsigned j = 0; j < 16; ++j) { const unsigned c = xb_ld(&bar[XB_XCNT(j)]); sum += c; cnt += (c > 0u) ? 1u : 0u; mine = (j == x) ? c : mine; }
        if (sum == G) break;
        __builtin_amdgcn_s_sleep(1);
        if ((++sp & 255u) == 0u) { if (xb_ld(&bar[XB_TMO])) break; if (sp > XB_SPIN_CAP) { atomicAdd(&bar[XB_TMO], 1u); break; } }
    }
    nloc = mine > 0u ? mine : 1u; nx = cnt > 0u ? cnt : 1u;
}
__device__ __forceinline__ void xcd_barrier(const XcdBarrier& b) {
    asm volatile("s_waitcnt vmcnt(0)" ::: "memory");
    __syncthreads();
    if (threadIdx.x == 0) {
        unsigned* bar = b.bar;
        __builtin_amdgcn_s_waitcnt(0);
        unsigned nloc = b.st[0], nx = b.st[1];
        if (nloc == 0u) { xcd_barrier_complete(bar, b.x, nloc, nx); b.st[0] = nloc; b.st[1] = nx; }
        const unsigned old = xb_add(&bar[XB_XSUB(b.x)], 1u);
        const unsigned gen = old / nloc;
        if (old + 1u == (gen + 1u) * nloc) {
            __builtin_amdgcn_fence(__ATOMIC_RELEASE, "agent");
            asm volatile("s_waitcnt vmcnt(0)" ::: "memory");
            const unsigned og = xb_add(&bar[XB_TOP], 1u);
            const unsigned tg = og / nx;
            if (og + 1u == (tg + 1u) * nx) xb_add(&bar[XB_TOPGEN], 1u);
            else XB_SPIN(xb_ld(&bar[XB_TOPGEN]) == tg, bar);
            __builtin_amdgcn_fence(__ATOMIC_ACQUIRE, "agent");
            xb_add(&bar[XB_XGEN(b.x)], 1u);
            asm volatile("s_waitcnt vmcnt(0)" ::: "memory");
        } else {
            XB_SPIN(xb_ld(&bar[XB_XGEN(b.x)]) == gen, bar);
            __builtin_amdgcn_fence(__ATOMIC_ACQUIRE, "agent");
            asm volatile("s_waitcnt vmcnt(0)" ::: "memory");
        }
    }
    __syncthreads();
}

struct Args {
    const float* x; const float* norm_in_w; const float* w_in; const float* conv_w; const float* conv_b; const float* dt_bias; const float* a_log; const float* d_skip;
    const float* ssm_norm_w; const float* q_norm_w; const float* w_uq; const float* kv_norm_w; const float* w_ukv; const float* w_bs; const float* w_ba; const float* w_out; const float* norm_final_w;
    float* out; unsigned char* ws; int ph_lo, ph_hi;
};
struct Frame {
    LAS unsigned char* lds; volatile LAS unsigned* MISC; gu32* ctl;
    int tid, lane, wave, vcu, G;
};
__device__ __forceinline__ float wave_sum(float v) {
#pragma unroll
    for (int o = 1; o < 64; o <<= 1) v += __shfl_xor(v, o);
    return v;
}

template <class F>
__device__ __forceinline__ void transpose_item(const float* W, int K, int N, bf16* WT, LAS float* scr, int item, int nblk, int lane, const float* kscale, F srccol) {
    const int kb = item / nblk, nb = item % nblk, k0 = 64 * kb, n0 = 32 * nb;
    const int sc = srccol(n0 + (lane & 31));
    float tv[32];
    { const float* wp = W + (size_t)(k0 + (lane >> 5)) * N + (sc >= 0 ? sc : 0);
#pragma unroll
      for (int i = 0; i < 32; ++i) tv[i] = wp[(size_t)(2 * i) * N]; }
#pragma unroll
    for (int i = 0; i < 32; ++i) { const int kk = 2 * i + (lane >> 5); float v = (sc >= 0) ? tv[i] : 0.f; if (kscale) v *= kscale[k0 + kk]; scr[kk * 33 + (lane & 31)] = v; }
    LDS_WAIT(); asm volatile("" ::: "memory");
    const int c = lane & 7;
#pragma unroll
    for (int j = 0; j < 4; ++j) { const int n = (lane >> 3) + 8 * j; const LAS float* s = scr + (8 * c) * 33 + n;
        v4u o; o.x = pk2(s[0 * 33], s[1 * 33]); o.y = pk2(s[2 * 33], s[3 * 33]); o.z = pk2(s[4 * 33], s[5 * 33]); o.w = pk2(s[6 * 33], s[7 * 33]);
        *(GAS v4u*)(WT + (size_t)(n0 + n) * K + k0 + 8 * c) = o; }
    LDS_WAIT(); asm volatile("" ::: "memory");
}
template <class F>
__device__ __forceinline__ void transpose_item8(const float* W, int K, int N, unsigned char* WT, int ldt, LAS float* scr, int item, int nblk, int lane, float oscale, F srccol, const float* kscale = nullptr) {
    const int kb = item / nblk, nb = item % nblk, k0 = 64 * kb, n0 = 32 * nb;
    const int sc = srccol(n0 + (lane & 31));
    float tv[32];
    { const float* wp = W + (size_t)(k0 + (lane >> 5)) * N + (sc >= 0 ? sc : 0);
#pragma unroll
      for (int i = 0; i < 32; ++i) tv[i] = wp[(size_t)(2 * i) * N]; }
#pragma unroll
    for (int i = 0; i < 32; ++i) { const int kk = 2 * i + (lane >> 5); float v = (sc >= 0) ? tv[i] * oscale : 0.f; if (kscale) v *= kscale[k0 + kk]; scr[kk * 33 + (lane & 31)] = v; }
    LDS_WAIT(); asm volatile("" ::: "memory");
    const int c = lane & 7;
#pragma unroll
    for (int j = 0; j < 4; ++j) { const int n = (lane >> 3) + 8 * j; const LAS float* sp = scr + (8 * c) * 33 + n;
        v2u o; o.x = pg8::pk4_fp8(sp[0 * 33], sp[1 * 33], sp[2 * 33], sp[3 * 33]); o.y = pg8::pk4_fp8(sp[4 * 33], sp[5 * 33], sp[6 * 33], sp[7 * 33]);
        *(GAS v2u*)(WT + (size_t)(n0 + n) * ldt + k0 + 8 * c) = o; }
    LDS_WAIT(); asm volatile("" ::: "memory");
}
struct SrcIn16 { __device__ __forceinline__ int operator()(int n) const {
    if (n < GC_DT) return n;
    if (n < GC_DT + 128) return n - GC_DT + SC_DT;
    return -1; } };
struct SrcIn8 { __device__ __forceinline__ int operator()(int n) const {
    n += PC_A0;
    if (n < PC_CQ) return n - PC_GSSM + SC_GSSM;
    if (n < PC_GATTN) return n - PC_CQ + SC_CQ;
    if (n < PC_GATT2) return n - PC_GATTN + SC_GATTN;
    if (n < PC_KV) return n - PC_GATT2 + SC_GATT2;
    if (n < PC_KV + 576) return n - PC_KV + SC_KV;
    return -1; } };
struct SrcUq { __device__ __forceinline__ int operator()(int n) const {
    if (n < 4096) return (n >> 7) * 192 + (n & 127);
    const int r = n - 4096, h = r >> 6, j = r & 63; return h * 192 + 128 + (j & 1) * 32 + (j >> 1); } };
struct SrcId { __device__ __forceinline__ int operator()(int n) const { return n; } };
struct SrcUkv { __device__ __forceinline__ int operator()(int n) const { const int r = n & 4095; return (r >> 7) * 256 + (n >> 12) * 128 + (r & 127); } };

struct TItem { const float* W; unsigned char* WT; const float* ksc; int K, N, ldt, nblk, r, map; float osc; bool f8; };
__device__ __forceinline__ int titem_src(int map, int n) { return map == 0 ? SrcIn16()(n) : map == 1 ? SrcIn8()(n) : map == 2 ? SrcUq()(n) : map == 3 ? SrcUkv()(n) : n; }
__device__ __forceinline__ bool titem_vec(const TItem& t) { return t.map != 2 || 32 * (t.r % t.nblk) < 4096; }
__device__ __forceinline__ void titem_load(const TItem& t, int lane, float (&tv)[32], int& sc) {
    const int kb = t.r / t.nblk, nb = t.r % t.nblk, k0 = 64 * kb, n0 = 32 * nb;
    if (titem_vec(t)) {
        sc = titem_src(t.map, n0);
        const float* wp = t.W + (size_t)(k0 + (lane >> 3)) * t.N + (sc >= 0 ? sc : 0) + 4 * (lane & 7);
#pragma unroll
        for (int i = 0; i < 8; ++i) { const f32x4 v = *(const GAS f32x4*)(wp + (size_t)(8 * i) * t.N); tv[4 * i] = v.x; tv[4 * i + 1] = v.y; tv[4 * i + 2] = v.z; tv[4 * i + 3] = v.w; }
        return;
    }
    sc = titem_src(t.map, n0 + (lane & 31));
    const float* wp = t.W + (size_t)(k0 + (lane >> 5)) * t.N + (sc >= 0 ? sc : 0);
#pragma unroll
    for (int i = 0; i < 32; ++i) tv[i] = wp[(size_t)(2 * i) * t.N];
}
__device__ __forceinline__ void titem_finish(const TItem& t, int lane, const float (&tv)[32], int sc, LAS float* scr) {
    const int kb = t.r / t.nblk, nb = t.r % t.nblk, k0 = 64 * kb, n0 = 32 * nb;
    if (titem_vec(t)) {
#pragma unroll
        for (int i = 0; i < 32; ++i) { const int kk = (lane >> 3) + 8 * (i >> 2), nn = 4 * (lane & 7) + (i & 3); float v = (sc >= 0) ? tv[i] * t.osc : 0.f; if (t.ksc) v *= t.ksc[k0 + kk]; scr[kk * 33 + nn] = v; }
    } else {
#pragma unroll
        for (int i = 0; i < 32; ++i) { const int kk = 2 * i + (lane >> 5); float v = (sc >= 0) ? tv[i] * t.osc : 0.f; if (t.ksc) v *= t.ksc[k0 + kk]; scr[kk * 33 + (lane & 31)] = v; }
    }
    LDS_WAIT(); asm volatile("" ::: "memory");
    const int c = lane & 7;
    if (t.f8) {
#pragma unroll
        for (int j = 0; j < 4; ++j) { const int n = (lane >> 3) + 8 * j; const LAS float* sp = scr + (8 * c) * 33 + n;
            v2u o; o.x = pg8::pk4_fp8(sp[0 * 33], sp[1 * 33], sp[2 * 33], sp[3 * 33]); o.y = pg8::pk4_fp8(sp[4 * 33], sp[5 * 33], sp[6 * 33], sp[7 * 33]);
            *(GAS v2u*)(t.WT + (size_t)(n0 + n) * t.ldt + k0 + 8 * c) = o; }
    } else {
#pragma unroll
        for (int j = 0; j < 4; ++j) { const int n = (lane >> 3) + 8 * j; const LAS float* sp = scr + (8 * c) * 33 + n;
            v4u o; o.x = pk2(sp[0 * 33], sp[1 * 33]); o.y = pk2(sp[2 * 33], sp[3 * 33]); o.z = pk2(sp[4 * 33], sp[5 * 33]); o.w = pk2(sp[6 * 33], sp[7 * 33]);
            *(GAS v4u*)(t.WT + (size_t)(n0 + n) * t.ldt + (size_t)(k0 + 8 * c) * 2) = o; }
    }
    LDS_WAIT(); asm volatile("" ::: "memory");
}
template <class Dec> __device__ __forceinline__ void transpose_stream(const Dec& dec, int total, int gw, int NGW, int lane, LAS float* scr) {
    int it = gw; if (it >= total) return;
    TItem cur = dec(it); float tva[32]; int sca; titem_load(cur, lane, tva, sca);
    for (;;) {
        const int itn = it + NGW; const bool hn = itn < total;
        TItem nxt = cur; float tvb[32]; int scb = -1;
        if (hn) { nxt = dec(itn); titem_load(nxt, lane, tvb, scb); }
        titem_finish(cur, lane, tva, sca, scr);
        if (!hn) break;
        cur = nxt; sca = scb; it = itn;
#pragma unroll
        for (int i = 0; i < 32; ++i) tva[i] = tvb[i];
    }
}

__device__ __forceinline__ void p0_prologue(Frame& F, const Args& a) {
    LAS float* scr = (LAS float*)(F.lds + RING_OFF + F.wave * 16384);
    const int gw = F.vcu * NWAVES + F.wave, NGW = F.G * NWAVES;
    unsigned char* ws = a.ws;
    f32x4 wn[16];
    { const GAS f32x4* wr = (const GAS f32x4*)a.norm_in_w + F.lane;
#pragma unroll
      for (int j = 0; j < 16; ++j) wn[j] = wr[64 * j]; }
    for (int m = gw; m < M; m += NGW) {
        const GAS f32x4* xr = (const GAS f32x4*)(a.x + (size_t)m * DM) + F.lane;
        f32x4 v[16]; float s = 0.f;
#pragma unroll
        for (int j = 0; j < 16; ++j) { v[j] = xr[64 * j]; s += (v[j].x * v[j].x + v[j].y * v[j].y) + (v[j].z * v[j].z + v[j].w * v[j].w); }
        const float rstd = 1.0f / sqrtf(wave_sum(s) * (1.f / DM) + EPS);
        GAS v2u* o8 = (GAS v2u*)((bf16*)(ws + WS_U) + (size_t)m * DM) + F.lane;
        GAS unsigned* u8 = (GAS unsigned*)(ws + WS_U8 + (size_t)m * DM) + F.lane;
#pragma unroll
        for (int j = 0; j < 16; ++j) { const f32x4 w = wn[j]; const float u0 = v[j].x * rstd * w.x, u1 = v[j].y * rstd * w.y, u2 = v[j].z * rstd * w.z, u3 = v[j].w * rstd * w.w;
            v2u o; o.x = pk2(u0, u1); o.y = pk2(u2, u3); o8[64 * j] = o; u8[64 * j] = pg8::pk4_fp8(u0, u1, u2, u3); }
    }
    for (int idx = (F.vcu * 512 + F.tid); idx < SEQ * 32; idx += F.G * 512) {
        const int t = idx >> 5, i = idx & 31;
        double f = 1.0; for (int k = 0; k < i; ++k) f *= 0.74989420933245582730;
        const double av = (double)t * f * 0.15915494309189533577;
        const float fr = (float)(av - __builtin_rint(av));
        ((float*)(ws + WS_COS))[idx] = __builtin_amdgcn_cosf(fr); ((float*)(ws + WS_SIN))[idx] = __builtin_amdgcn_sinf(fr);
    }
    constexpr int I_IN = (DM / 64) * (N16 / 32), I_IN8 = (DM / 64) * (N8 / 32), I_UQ = (Q_LORA / 64) * (6144 / 32), I_UKV = (KV_LORA / 64) * (8192 / 32);
    auto dec = [&](int it) -> TItem {
        int r = it;
        if (r < I_IN) return TItem{a.w_in, ws + WS_WIN, nullptr, DM, D_IN, DM * 2, N16 / 32, r, 0, 1.0f, false}; r -= I_IN;
        if (r < I_IN8) return TItem{a.w_in, ws + WS_WIN8, nullptr, DM, D_IN, DM, N8 / 32, r, 1, 64.0f, true}; r -= I_IN8;
        if (r < I_UQ) return TItem{a.w_uq, ws + WS_WUQ, a.q_norm_w, Q_LORA, 6144, Q_LORA, 6144 / 32, r, 2, 32.0f, true}; r -= I_UQ;
        return TItem{a.w_ukv, ws + WS_WUKV, a.kv_norm_w, KV_LORA, 8192, KV_LORA, 8192 / 32, r, 3, 32.0f, true}; };
    transpose_stream(dec, I_IN + I_IN8 + I_UQ + I_UKV, gw, NGW, F.lane, scr);
}

#ifndef CONV_RG
#define CONV_RG 32
#endif
__device__ __forceinline__ void p2_thin(Frame& F, const Args& a) {
    unsigned char* ws = a.ws;
    const bf16* PROJ = (const bf16*)(ws + WS_PROJ); bf16* XBC = (bf16*)(ws + WS_XBC);
    const int gw = F.vcu * NWAVES + F.wave, NGW = F.G * NWAVES;
    for (int it = gw; it < (M / 32) * 20; it += NGW) {
        const int rb = it / 20, sg = it % 20, c0 = sg * 512 + F.lane * 8, m0 = rb * 32, t0 = m0 & (SEQ - 1);
        float w[4][8], bb[8];
#pragma unroll
        for (int k = 0; k < 4; ++k) { const f32x4 w0 = *(const GAS f32x4*)(a.conv_w + k * D_CONV + c0), w1 = *(const GAS f32x4*)(a.conv_w + k * D_CONV + c0 + 4);
            w[k][0] = w0.x; w[k][1] = w0.y; w[k][2] = w0.z; w[k][3] = w0.w; w[k][4] = w1.x; w[k][5] = w1.y; w[k][6] = w1.z; w[k][7] = w1.w; }
        { const f32x4 b0 = *(const GAS f32x4*)(a.conv_b + c0), b1 = *(const GAS f32x4*)(a.conv_b + c0 + 4); bb[0] = b0.x; bb[1] = b0.y; bb[2] = b0.z; bb[3] = b0.w; bb[4] = b1.x; bb[5] = b1.y; bb[6] = b1.z; bb[7] = b1.w; }
        const bf16* src = PROJ + (size_t)m0 * NP + PC_XBC + c0;
        v4u r0 = {0, 0, 0, 0}, r1 = r0, r2 = r0;
        if (t0 != 0) { r0 = *(const GAS v4u*)(src - 3 * (size_t)NP); r1 = *(const GAS v4u*)(src - 2 * (size_t)NP); r2 = *(const GAS v4u*)(src - (size_t)NP); }
        for (int rg = 0; rg < 32; rg += CONV_RG) {
            v4u rr[CONV_RG];
#pragma unroll
            for (int r8 = 0; r8 < CONV_RG; ++r8) rr[r8] = *(const GAS v4u*)(src + (size_t)(rg + r8) * NP);
#pragma unroll
        for (int r8 = 0; r8 < CONV_RG; ++r8) { const int r = rg + r8;
            const v4u r3 = rr[r8];
            float o[8];
#pragma unroll
            for (int j = 0; j < 4; ++j) {
                o[2 * j]     = bb[2 * j]     + w[0][2 * j]     * bflo(r0[j]) + w[1][2 * j]     * bflo(r1[j]) + w[2][2 * j]     * bflo(r2[j]) + w[3][2 * j]     * bflo(r3[j]);
                o[2 * j + 1] = bb[2 * j + 1] + w[0][2 * j + 1] * bfhi(r0[j]) + w[1][2 * j + 1] * bfhi(r1[j]) + w[2][2 * j + 1] * bfhi(r2[j]) + w[3][2 * j + 1] * bfhi(r3[j]);
            }
            v4u ov; ov.x = pk2(silu_(o[0]), silu_(o[1])); ov.y = pk2(silu_(o[2]), silu_(o[3])); ov.z = pk2(silu_(o[4]), silu_(o[5])); ov.w = pk2(silu_(o[6]), silu_(o[7]));
            *(GAS v4u*)(XBC + (size_t)(m0 + r) * D_CONV + c0) = ov;
            r0 = r1; r1 = r2; r2 = r3;
        } }
    }
    for (int it = gw; it < 256; it += NGW) {
        const int hh = (it & 1) * 64 + F.lane; const size_t m0 = (size_t)(it >> 1) * CHUNK;
        float* dtp = (float*)(ws + WS_DT32) + m0 * 128 + hh; float* acp = (float*)(ws + WS_ACS) + m0 * 128 + hh;
        const float Ah = -__expf(a.a_log[hh]), dtb = a.dt_bias[hh]; float acc = 0.f;
        for (int r0 = 0; r0 < CHUNK; r0 += 16) { float raw[16];
#pragma unroll
            for (int r = 0; r < 16; ++r) raw[r] = dtp[(size_t)(r0 + r) * 128];
#pragma unroll
            for (int r = 0; r < 16; ++r) { const float x = raw[r] + dtb; float dt; if (x > 20.f) dt = x; else { const float y = __expf(x); dt = y < 0.01f ? y * (1.0f - y * (0.5f - 0.33333333f * y)) : __logf(1.0f + y); }
                acc += dt * Ah; dtp[(size_t)(r0 + r) * 128] = dt; acp[(size_t)(r0 + r) * 128] = acc; } }
    }
    for (int mb = gw; mb < M; mb += 4 * NGW) {
        v4u q0[4], q1[4], k0[4]; float x1[4], x2[4], cc[4], ss[4];
#pragma unroll
        for (int u = 0; u < 4; ++u) { const int m = (mb + u * NGW < M) ? mb + u * NGW : mb; const bf16* pr = PROJ + (size_t)m * NP;
            q0[u] = *(const GAS v4u*)(pr + PC_CQ + F.lane * 16); q1[u] = *(const GAS v4u*)(pr + PC_CQ + F.lane * 16 + 8); k0[u] = *(const GAS v4u*)(pr + PC_KV + F.lane * 8);
            const int t = m & (SEQ - 1), i = F.lane & 31; x1[u] = bf2f(pr[PC_KV + 512 + i]); x2[u] = bf2f(pr[PC_KV + 544 + i]); cc[u] = ((const float*)(ws + WS_COS))[t * 32 + i]; ss[u] = ((const float*)(ws + WS_SIN))[t * 32 + i]; }
#pragma unroll
        for (int u = 0; u < 4; ++u) { const int m = mb + u * NGW; if (m >= M) break;
            float sq = 0.f, sk = 0.f;
#pragma unroll
            for (int j = 0; j < 4; ++j) { float a0 = bflo(q0[u][j]), a1 = bfhi(q0[u][j]), a2 = bflo(q1[u][j]), a3 = bfhi(q1[u][j]); sq += a0 * a0 + a1 * a1 + a2 * a2 + a3 * a3; float y0 = bflo(k0[u][j]), y1 = bfhi(k0[u][j]); sk += y0 * y0 + y1 * y1; }
            sq = wave_sum(sq); sk = wave_sum(sk);
            if (F.lane == 0) { ((float*)(ws + WS_RSTDQ))[m] = 1.0f / sqrtf(sq * (1.f / Q_LORA) + EPS); ((float*)(ws + WS_RSTDKV))[m] = 1.0f / sqrtf(sk * (1.f / KV_LORA) + EPS); }
            if (F.lane < 32) { const float re = x1[u] * cc[u] - x2[u] * ss[u], im = x2[u] * cc[u] + x1[u] * ss[u];
                ((unsigned*)(ws + WS_KROPE))[(size_t)m * 32 + F.lane] = pk2(re, im);
                ((unsigned short*)(ws + WS_KR8))[(size_t)m * 32 + F.lane] = (unsigned short)__builtin_amdgcn_cvt_pk_fp8_f32(re, im, 0, false); } }
    }
}

__host__ __device__ __forceinline__ unsigned off_a(unsigned row, unsigned ch) { return 2048u * (row >> 3) + 512u * (ch >> 2) + 64u * (row & 7) + 16u * ((ch & 3) ^ ((row >> 2) & 3)); }
struct ImgA { unsigned rb0, rb1, tb0, tb1; };
__device__ __forceinline__ ImgA imga_bases(int lane) { const unsigned r32 = lane & 31, hi = lane >> 5, qq = (lane & 15) >> 2, pp = lane & 3, blk = (lane >> 4) & 1; ImgA g;
    g.rb0 = off_a(r32, hi); g.rb1 = off_a(r32, 2 + hi);
    g.tb0 = 2048u * hi + 64u * qq + 16u * ((2 * blk + (pp >> 1)) ^ (2 * hi)) + 8u * (pp & 1);
    g.tb1 = 2048u * hi + 64u * (4 + qq) + 16u * ((2 * blk + (pp >> 1)) ^ (2 * hi + 1)) + 8u * (pp & 1); return g; }
#define MFMA32(A, B, C) __builtin_amdgcn_mfma_f32_32x32x16_bf16(A, B, C, 0, 0, 0)
#define PK4(P, B_, OUT) do { unsigned a0 = cvtpk(P[B_+0], P[B_+1]), a1 = cvtpk(P[B_+2], P[B_+3]); unsigned b0 = cvtpk(P[B_+4], P[B_+5]), b1 = cvtpk(P[B_+6], P[B_+7]); \
        auto r0 = __builtin_amdgcn_permlane32_swap(a0, b0, false, false); auto r1 = __builtin_amdgcn_permlane32_swap(a1, b1, false, false); \
        v4u w_ = {r0[0], r1[0], r0[1], r1[1]}; OUT = __builtin_bit_cast(bf16x8, w_); } while (0)
__device__ __forceinline__ bf16x8 mk8(s16x4 lo, s16x4 hi) { return (bf16x8){lo[0], lo[1], lo[2], lo[3], hi[0], hi[1], hi[2], hi[3]}; }
#define RD128(addr) (*(const LAS bf16x8*)(uintptr_t)(addr))
#define SBAR() __builtin_amdgcn_sched_barrier(0)

namespace ssd {
constexpr int BT_OFF = 0, CT_OFF = 32768, XT_OFF = 65536, XS_OFF = 98304, HB_OFF = 114688;
constexpr int T_ACS = SSD_TAB_OFF, T_EA = SSD_TAB_OFF + 512, T_DT = SSD_TAB_OFF + 1024, T_CD = SSD_TAB_OFF + 1536, SP_OFF = SSD_TAB_OFF + 2048;
static_assert(SP_OFF + 10 * 2048 <= LDS_BYTES && HB_OFF + 16384 <= RING_BYTES, "SSD LDS map");

template <int MODE = 0> __device__ __forceinline__ void ssd_phase(Frame& F, const Args& a, bool dry = false) {
    unsigned char* ws = a.ws; bf16* XBC = (bf16*)(ws + WS_XBC); const float* DTV = (const float*)(ws + WS_DT32); const float* ACS = (const float*)(ws + WS_ACS);
    const int tid = F.tid, lane = F.lane, wid = F.wave, r32 = lane & 31, hi = lane >> 5;
    const unsigned lds0 = (unsigned)(uintptr_t)F.lds; LAS unsigned char* L = F.lds;
    const int li = wid >> 1, pb = wid & 1;
    const int qq = (lane & 15) >> 2, pp = lane & 3, blk = (lane >> 4) & 1;
    ImgA ia = imga_bases(lane);
    unsigned xtb = (8 * hi + qq) * 64 + blk * 32 + pp * 8;
    const int ti0 = (wid == 0) ? 0 : (wid == 1) ? 1 : (wid == 2) ? 1 : (wid <= 5) ? 2 : 3, tj0 = (wid == 0) ? 0 : (wid == 1) ? 0 : (wid == 2) ? 1 : (wid == 3) ? 0 : (wid == 4) ? 1 : (wid == 5) ? 2 : (wid == 6) ? 2 : 3;
    const int ntile = (MODE == 2) ? 0 : (wid < 2) ? 2 : 1, ti1 = 3, tj1 = wid;
    for (int item = F.vcu; item < 256; item += F.G) {
        const int b = item >> 7, hh = item & 127, g = hh >> 4;
        const float Dh = a.d_skip[hh];
        f32x16 hacc = {};
        for (int i = tid; i < 16384 / 16; i += 512) *(LAS v4u*)(L + HB_OFF + i * 16) = (v4u){0, 0, 0, 0};
        v4u pB[4], pC[4]; v4u pXa[2], pXb[2]; float paca[2], pdta[2], pala, pacb[2], pdtb[2], palb;
#define SSD_LOADBC(T) do { const size_t m0_ = (size_t)b * SEQ + (size_t)(T) * CHUNK; \
            _Pragma("unroll") for (int j = 0; j < 4; ++j) { const int q_ = tidv + 512 * j, row_ = q_ >> 4, ch_ = q_ & 15; const bf16* p_ = XBC + (m0_ + row_) * D_CONV + D_SSM + g * 128 + ch_ * 8; pB[j] = *(const GAS v4u*)p_; pC[j] = *(const GAS v4u*)(p_ + 1024); } } while (0)
#define SSD_LOADX(T, pX, pac, pdt, pal) do { const size_t m0_ = (size_t)b * SEQ + (size_t)(T) * CHUNK; \
            _Pragma("unroll") for (int j = 0; j < 2; ++j) { const int q_ = tidv + 512 * j, row_ = q_ >> 3, ch_ = q_ & 7; pX[j] = *(const GAS v4u*)(XBC + (m0_ + row_) * D_CONV + hh * 64 + ch_ * 8); \
                pac[j] = ACS[(m0_ + row_) * 128 + hh]; pdt[j] = DTV[(m0_ + row_) * 128 + hh]; } \
            pal = ACS[(m0_ + 127) * 128 + hh]; } while (0)
#define SSD_WRITE(XB, pX, pac, pdt, pal) do { \
            _Pragma("unroll") for (int j = 0; j < 4; ++j) { const int q_ = tidv + 512 * j, row_ = q_ >> 4, ch_ = q_ & 15; *(LAS v4u*)(L + BT_OFF + off_a(row_, ch_)) = pB[j]; *(LAS v4u*)(L + CT_OFF + off_a(row_, ch_)) = pC[j]; } \
            _Pragma("unroll") for (int j = 0; j < 2; ++j) { const int q_ = tidv + 512 * j, row_ = q_ >> 3, ch_ = q_ & 7; const unsigned ad_ = (ch_ >> 2) * 8192 + row_ * 64 + (ch_ & 3) * 16; \
                const float wv_ = pdt[j] * __expf(pal - pac[j]); const v4u x_ = pX[j]; *(LAS v4u*)(L + XT_OFF + (XB) * 16384 + ad_) = x_; \
                v4u xs_; xs_.x = pk2(bflo(x_.x) * wv_, bfhi(x_.x) * wv_); xs_.y = pk2(bflo(x_.y) * wv_, bfhi(x_.y) * wv_); xs_.z = pk2(bflo(x_.z) * wv_, bfhi(x_.z) * wv_); xs_.w = pk2(bflo(x_.w) * wv_, bfhi(x_.w) * wv_); \
                *(LAS v4u*)(L + XS_OFF + ad_) = xs_; \
                if (ch_ == 0) { ((LAS float*)(L + T_ACS))[row_] = pac[j]; ((LAS float*)(L + T_EA))[row_] = __expf(pac[j]); ((LAS float*)(L + T_DT))[row_] = pdt[j]; } } \
            if (tidv == 0) *(LAS float*)(L + T_CD) = __expf(pal); } while (0)
        int tidv = tid; asm volatile("" : "+v"(tidv));
        SSD_LOADBC(0); SSD_LOADX(0, pXa, paca, pdta, pala); SSD_WRITE(0, pXa, paca, pdta, pala);
        SSD_LOADX(1, pXb, pacb, pdtb, palb);
        LDS_WAIT(); __syncthreads();
#define SSD_ITER(T, XNX, XNac, XNdt, XNal, XFX, XFac, XFdt, XFal) do { \
            asm volatile("" : "+v"(ia.rb0), "+v"(ia.rb1), "+v"(ia.tb0), "+v"(ia.tb1), "+v"(xtb), "+v"(tidv)); \
            if (MODE != 3 && (T) + 1 < SEQ / CHUNK) SSD_LOADBC((T) + 1); \
              \
            const unsigned cbase0 = lds0 + CT_OFF + 8192 * li + ia.rb0, cbase1 = lds0 + CT_OFF + 8192 * li + ia.rb1; \
            f32x16 yacc = {}; \
            if (MODE != 4) { const unsigned hb0 = lds0 + HB_OFF + 8192 * pb + ia.rb0, hb1 = lds0 + HB_OFF + 8192 * pb + ia.rb1; \
              bf16x8 cf[2], hf[2]; cf[0] = RD128(cbase0); hf[0] = RD128(hb0); \
              _Pragma("unroll") for (int ks = 0; ks < 8; ++ks) { if (ks < 7) { cf[(ks + 1) & 1] = RD128((((ks + 1) & 1) ? cbase1 : cbase0) + 512 * ((ks + 1) >> 1)); hf[(ks + 1) & 1] = RD128((((ks + 1) & 1) ? hb1 : hb0) + 512 * ((ks + 1) >> 1)); } \
                  yacc = MFMA32(cf[ks & 1], hf[ks & 1], yacc); } } \
            _Pragma("unroll") for (int r = 0; r < 16; ++r) yacc[r] *= ((const LAS float*)(L + T_EA))[32 * li + crow(r, hi)]; \
            SBAR(); \
            if (MODE != 4) { const float cd = *(const LAS float*)(L + T_CD); \
              _Pragma("unroll") for (int r = 0; r < 16; ++r) hacc[r] *= cd; \
              const unsigned ax = lds0 + XS_OFF + pb * 8192 + xtb, bt0 = lds0 + BT_OFF + ia.tb0 + 512 * li, bt1 = lds0 + BT_OFF + ia.tb1 + 512 * li; \
              bf16x8 af[2], bq[2]; af[0] = mk8(tr_read(ax), tr_read(ax + 256)); bq[0] = mk8(tr_read(bt0), tr_read(bt1)); \
              _Pragma("unroll") for (int ks = 0; ks < 8; ++ks) { if (ks < 7) { af[(ks + 1) & 1] = mk8(tr_read(ax + 1024 * (ks + 1)), tr_read(ax + 1024 * (ks + 1) + 256)); bq[(ks + 1) & 1] = mk8(tr_read(bt0 + 4096 * (ks + 1)), tr_read(bt1 + 4096 * (ks + 1))); } \
                  hacc = MFMA32(af[ks & 1], bq[ks & 1], hacc); } } \
            SBAR(); \
            _Pragma("nounroll") for (int tt = 0; tt < ntile; ++tt) { \
                const int ti = tt ? ti1 : ti0, tj = tt ? tj1 : tj0; \
                f32x16 cbt = {}; \
                { const unsigned bb0 = lds0 + BT_OFF + 8192 * tj + ia.rb0, bb1 = lds0 + BT_OFF + 8192 * tj + ia.rb1, cc0 = lds0 + CT_OFF + 8192 * ti + ia.rb0, cc1 = lds0 + CT_OFF + 8192 * ti + ia.rb1; \
                  bf16x8 bf_[2], cf[2]; bf_[0] = RD128(bb0); cf[0] = RD128(cc0); \
                  _Pragma("unroll") for (int ks = 0; ks < 8; ++ks) { if (ks < 7) { bf_[(ks + 1) & 1] = RD128((((ks + 1) & 1) ? bb1 : bb0) + 512 * ((ks + 1) >> 1)); cf[(ks + 1) & 1] = RD128((((ks + 1) & 1) ? cc1 : cc0) + 512 * ((ks + 1) >> 1)); } \
                      cbt = MFMA32(bf_[ks & 1], cf[ks & 1], cbt); } } \
                const float acs_l = ((const LAS float*)(L + T_ACS))[32 * ti + r32]; \
                const bool diag = (ti == tj); \
                _Pragma("unroll") for (int r4 = 0; r4 < 4; ++r4) { const int s0_ = 32 * tj + 8 * r4 + 4 * hi; \
                    const f32x4 as4 = *(const LAS f32x4*)(L + T_ACS + 4 * s0_), ds4 = *(const LAS f32x4*)(L + T_DT + 4 * s0_); \
                    _Pragma("unroll") for (int e = 0; e < 4; ++e) { const int r = 4 * r4 + e, sl = 8 * r4 + 4 * hi + e; \
                        float v = cbt[r] * __expf(fminf(acs_l - as4[e], 0.f)) * ds4[e]; \
                        if (diag) { v = (sl > r32) ? 0.f : v; v += (sl == r32) ? Dh : 0.f; } \
                        cbt[r] = v; } } \
                bf16x8 pa0, pa1; \
                PK4(cbt, 0, pa0); PK4(cbt, 8, pa1); \
                const unsigned sp = lds0 + SP_OFF + (ti * (ti + 1) / 2 + tj) * 2048 + lane * 16; \
                *(LAS bf16x8*)(uintptr_t)sp = pa0; *(LAS bf16x8*)(uintptr_t)(sp + 1024) = pa1; \
            } \
            LDS_WAIT(); __syncthreads(); \
              \
            { const unsigned xa = lds0 + XT_OFF + ((T) & 1) * 16384 + pb * 8192 + xtb, sp = lds0 + SP_OFF + (li * (li + 1) / 2) * 2048 + lane * 16; \
              _Pragma("nounroll") for (int j = 0; j <= li; ++j) { \
                  const bf16x8 pa0 = RD128(sp + j * 2048), pa1 = RD128(sp + j * 2048 + 1024); \
                  const bf16x8 x0 = mk8(tr_read(xa + (32 * j) * 64), tr_read(xa + (32 * j) * 64 + 256)), x1 = mk8(tr_read(xa + (32 * j + 16) * 64), tr_read(xa + (32 * j + 16) * 64 + 256)); \
                  yacc = MFMA32(pa0, x0, yacc); yacc = MFMA32(pa1, x1, yacc); } } \
            if (!dry) { bf16* yp = XBC + ((size_t)b * SEQ + (size_t)(T) * CHUNK + 32 * li) * D_CONV + hh * 64 + 32 * pb + r32; \
              _Pragma("unroll") for (int r = 0; r < 16; ++r) yp[(size_t)crow(r, hi) * D_CONV] = (bf16)f2bf(yacc[r]); } \
            _Pragma("unroll") for (int r = 0; r < 16; ++r) { const int p = 32 * pb + crow(r, hi), n = 32 * li + r32; *(LAS bf16*)(L + HB_OFF + off_a(p, n >> 3) + (n & 7) * 2) = (bf16)f2bf(hacc[r]); } \
            asm volatile("" : "+v"(tidv)); \
            if (MODE != 3 && (T) + 1 < SEQ / CHUNK) { SSD_WRITE(((T) + 1) & 1, XNX, XNac, XNdt, XNal); if ((T) + 2 < SEQ / CHUNK) SSD_LOADX((T) + 2, XFX, XFac, XFdt, XFal); } \
            LDS_WAIT(); __syncthreads(); } while (0)
        for (int T = 0; T < SEQ / CHUNK; T += 2) {
            SSD_ITER(T, pXb, pacb, pdtb, palb, pXa, paca, pdta, pala);
            SSD_ITER(T + 1, pXa, paca, pdta, pala, pXb, pacb, pdtb, palb);
        }
#undef SSD_ITER
#undef SSD_LOADBC
#undef SSD_LOADX
#undef SSD_WRITE
    }
}
}

namespace att {
constexpr int KN_OFF = 0, KR_OFF = 32768, VT_OFF = 49152, QR_OFF = 98304, WS_OFF = SSD_TAB_OFF;
static_assert(QR_OFF + 8 * 4096 <= RING_BYTES && WS_OFF + 8 * 256 <= LDS_BYTES && WS_OFF >= MISC_OFF + 128, "attention LDS map");
constexpr int _unused_att = 0;
constexpr float SCALE = 0.07216878364870322f, C2 = SCALE * 1.4426950408889634f, THR = 8.f;
__device__ __forceinline__ void inv_a(int P, int& row, int& ch) { row = 8 * (P >> 7) + ((P >> 2) & 7); ch = 4 * ((P >> 5) & 3) + ((P & 3) ^ ((row >> 2) & 3)); }

template <int MODE = 0>
__device__ __forceinline__ void attn_phase(Frame& F, const Args& a) {
    unsigned char* ws = a.ws;
    const bf16* QN = (const bf16*)(ws + WS_QN); const bf16* QR = (const bf16*)(ws + WS_QR); const bf16* KV = (const bf16*)(ws + WS_KV); const bf16* KRP = (const bf16*)(ws + WS_KROPE);
    const bf16* PROJ = (const bf16*)(ws + WS_PROJ); bf16* O = (bf16*)(ws + WS_O);
    const int wid = F.wave;
    const bool late = wid >= 4;
    const unsigned lds0 = (unsigned)(uintptr_t)F.lds; LAS unsigned char* L = F.lds;
    LAS float* wsf = (LAS float*)(L + WS_OFF) + wid * 64;
#define WAITBAR() asm volatile("s_waitcnt vmcnt(0) lgkmcnt(0)\n\ts_barrier" ::: "memory")
    for (int v = F.vcu; v < 256; v += F.G) {
        const int bh = v >> 2, s4 = v & 3, b = bh >> 5, h = bh & 31; const size_t rowbase = (size_t)b * SEQ;
        for (int ui = 0; ui < 8; ++ui) {
            int lane = F.lane; asm volatile("" : "+v"(lane));
            const int r32 = lane & 31, hi = lane >> 5;
            ImgA ia = imga_bases(lane);
            unsigned koff[2], roff;
#pragma unroll
            for (int j = 0; j < 2; ++j) { int row, ch; inv_a((2 * wid + j) * 64 + lane, row, ch); koff[j] = (unsigned)(((rowbase + row) * 8192 + h * 256 + ch * 8) * 2); }
            { int R, ch; inv_a(wid * 64 + lane, R, ch); const int key = R + 32 * (ch >> 3), c = ch & 7; roff = (unsigned)(((rowbase + key) * 64 + c * 8) * 2); }
            const int qb = (ui & 1) ? (31 - (s4 + 4 * (ui >> 1))) : (s4 + 4 * (ui >> 1));
            const int q0 = qb * 256, NT = 4 * qb + 4, qrow = q0 + 32 * wid + r32;
            bf16x8 qn[8];
            const unsigned qrl = lds0 + QR_OFF + wid * 4096 + lane * 16;
            { const bf16* qp = QN + (rowbase + qrow) * 4096 + h * 128 + hi * 8;
#pragma unroll
              for (int d0 = 0; d0 < 8; ++d0) qn[d0] = *(const GAS bf16x8*)(qp + d0 * 16);
              const bf16* rp = QR + (rowbase + qrow) * 2048 + h * 64 + hi * 8;
#pragma unroll
              for (int d0 = 0; d0 < 4; ++d0) { const bf16x8 q_ = *(const GAS bf16x8*)(rp + d0 * 16); *(LAS bf16x8*)(uintptr_t)(qrl + d0 * 1024) = q_; }
#pragma unroll
              for (int d0 = 0; d0 < 8; ++d0) asm volatile("" : "+v"(qn[d0])); }
#define ATT_DMA(t) do { if (MODE == 1) break; const unsigned ks_ = ((t) & 1), vs_ = (unsigned)(t) % 3u; \
                _Pragma("unroll") for (int j = 0; j < 2; ++j) { glds16(KV, koff[j] + (unsigned)(t) * (64u * 8192u * 2u), (unsigned)__builtin_amdgcn_readfirstlane(lds0 + KN_OFF + ks_ * 16384 + (2 * wid + j) * 1024)); \
                glds16(KV + 128, koff[j] + (unsigned)(t) * (64u * 8192u * 2u), (unsigned)__builtin_amdgcn_readfirstlane(lds0 + VT_OFF + vs_ * 16384 + (2 * wid + j) * 1024)); } \
                glds16(KRP, roff + (unsigned)(t) * (64u * 64u * 2u), (unsigned)__builtin_amdgcn_readfirstlane(lds0 + KR_OFF + ks_ * 8192 + wid * 1024)); } while (0)
            float m_reg = -1e30f, l_reg = 0.f; f32x16 o[4] = {};
            ATT_DMA(0);
            if (late) { WAITBAR(); if (1 < NT) ATT_DMA(1); }
            for (int t = 0; t < NT; ++t) {
                if (!late) { WAITBAR(); if (t + 1 < NT) ATT_DMA(t + 1); }
                asm volatile("" : "+v"(ia.rb0), "+v"(ia.rb1), "+v"(ia.tb0), "+v"(ia.tb1));
                const bool act = (MODE != 2) && (64 * t <= q0 + 32 * wid + 31);
                bf16x8 pa0, pa1, pa2, pa3; float alpha = 1.f;
                if (act) {
                    f32x16 p0 = {}, p1 = {};
                    { const unsigned kb0 = lds0 + KN_OFF + (t & 1) * 16384 + ia.rb0, kb1 = lds0 + KN_OFF + (t & 1) * 16384 + ia.rb1;
                      const unsigned rb0_ = lds0 + KR_OFF + (t & 1) * 8192 + ia.rb0, rb1_ = lds0 + KR_OFF + (t & 1) * 8192 + ia.rb1;
                      bf16x8 kf[3][2], qf[3];
#define ATT_KRD(i, slot) do { if ((i) < 8) { const unsigned ad_ = (((i) & 1) ? kb1 : kb0) + 512 * ((i) >> 1); kf[slot][0] = RD128(ad_); kf[slot][1] = RD128(ad_ + 8192); } \
                              else if ((i) < 12) { const unsigned ad_ = ((((i) - 8) & 1) ? rb1_ : rb0_) + 512 * (((i) - 8) >> 1); kf[slot][0] = RD128(ad_); kf[slot][1] = RD128(ad_ + 1024); qf[slot] = RD128(qrl + ((i) - 8) * 1024); } } while (0)
                      ATT_KRD(0, 0); ATT_KRD(1, 1);
#pragma unroll
                      for (int i = 0; i < 12; ++i) {
                        ATT_KRD(i + 2, (i + 2) % 3);
                        const bf16x8 qo = (i < 8) ? qn[i < 8 ? i : 0] : qf[i % 3];
                        p0 = MFMA32(kf[i % 3][0], qo, p0); p1 = MFMA32(kf[i % 3][1], qo, p1); SBAR(); }
#undef ATT_KRD
                    }
                    if (64 * t + 63 > q0 + 32 * wid) { const int dq = qrow - 64 * t - 4 * hi; const float NEG = -__builtin_inff();
#pragma unroll
                        for (int r = 0; r < 16; ++r) { const int c_ = (r & 3) + 8 * (r >> 2); if (c_ > dq) p0[r] = NEG; if (c_ + 32 > dq) p1[r] = NEG; } }
                    float pmax = p0[0];
#pragma unroll
                    for (int r = 1; r < 16; ++r) pmax = fmaxf(pmax, p0[r]);
#pragma unroll
                    for (int r = 0; r < 16; ++r) pmax = fmaxf(pmax, p1[r]);
                    { auto rr = __builtin_amdgcn_permlane32_swap(__float_as_uint(pmax), __float_as_uint(pmax), false, false); pmax = fmaxf(__uint_as_float(rr[0]), __uint_as_float(rr[1])); }
                    if (!__all((pmax - m_reg) * SCALE <= THR)) { const float mn = fmaxf(m_reg, pmax); alpha = __builtin_amdgcn_exp2f((m_reg - mn) * C2); m_reg = mn;
                        if (hi == 0) wsf[r32] = alpha; LDS_WAIT();
#pragma unroll
                        for (int d_ = 0; d_ < 4; ++d_)
#pragma unroll
                            for (int r = 0; r < 16; ++r) o[d_][r] *= wsf[crow(r, hi)]; }
                    const float mnL = -m_reg * C2; float ps = 0.f;
#pragma unroll
                    for (int r = 0; r < 16; ++r) { p0[r] = __builtin_amdgcn_exp2f(fmaf(p0[r], C2, mnL)); p1[r] = __builtin_amdgcn_exp2f(fmaf(p1[r], C2, mnL)); ps += p0[r] + p1[r]; }
                    l_reg = l_reg * alpha + ps;
                    PK4(p0, 0, pa0); PK4(p0, 8, pa1); PK4(p1, 0, pa2); PK4(p1, 8, pa3); SBAR();
                }
                if (late) { WAITBAR(); if (t + 2 < NT) ATT_DMA(t + 2); }
                if (act) {
                    const unsigned vs_ = (unsigned)t % 3u; const unsigned vb0 = lds0 + VT_OFF + vs_ * 16384 + ia.tb0, vb1 = lds0 + VT_OFF + vs_ * 16384 + ia.tb1;
                    bf16x8 vc0 = mk8(tr_read(vb0), tr_read(vb1)), vc1 = mk8(tr_read(vb0 + 4096), tr_read(vb1 + 4096)), vc2 = mk8(tr_read(vb0 + 8192), tr_read(vb1 + 8192)), vc3 = mk8(tr_read(vb0 + 12288), tr_read(vb1 + 12288)), vn0, vn1, vn2, vn3;
#pragma unroll
                    for (int dv = 0; dv < 4; ++dv) {
                        if (dv < 3) { const unsigned o_ = 512 * (dv + 1); vn0 = mk8(tr_read(vb0 + o_), tr_read(vb1 + o_)); vn1 = mk8(tr_read(vb0 + o_ + 4096), tr_read(vb1 + o_ + 4096)); vn2 = mk8(tr_read(vb0 + o_ + 8192), tr_read(vb1 + o_ + 8192)); vn3 = mk8(tr_read(vb0 + o_ + 12288), tr_read(vb1 + o_ + 12288)); }
                        o[dv] = MFMA32(pa0, vc0, o[dv]); o[dv] = MFMA32(pa1, vc1, o[dv]); o[dv] = MFMA32(pa2, vc2, o[dv]); o[dv] = MFMA32(pa3, vc3, o[dv]); vc0 = vn0; vc1 = vn1; vc2 = vn2; vc3 = vn3; SBAR(); }
                }
            }
            if (!late) WAITBAR();
            { auto rr = __builtin_amdgcn_permlane32_swap(__float_as_uint(l_reg), __float_as_uint(l_reg), false, false); l_reg = __uint_as_float(rr[0]) + __uint_as_float(rr[1]); }
            if (hi == 0) wsf[32 + r32] = l_reg; LDS_WAIT();
            LAS bf16* stg = (LAS bf16*)(L + wid * 4096);
#pragma unroll
            for (int ps_ = 0; ps_ < 2; ++ps_) {
                v4u gvs[4];
#pragma unroll
                for (int i = 0; i < 4; ++i) { const int row = i * 4 + (lane >> 4), ch = lane & 15; const size_t mrow = rowbase + q0 + 32 * wid + 16 * ps_ + row; gvs[i] = *(const GAS v4u*)(PROJ + mrow * NP + PC_GATTN + h * 128 + ch * 8); }
#pragma unroll
                for (int r8 = 0; r8 < 8; ++r8) { const int r = 8 * ps_ + r8, orow = crow(r, hi); const float rl = __builtin_amdgcn_rcpf(wsf[32 + orow]);
#pragma unroll
                    for (int dv = 0; dv < 4; ++dv) stg[(orow - 16 * ps_) * 128 + dv * 32 + r32] = (bf16)f2bf(o[dv][r] * rl); }
                LDS_WAIT();
#pragma unroll
                for (int i = 0; i < 4; ++i) { const int row = i * 4 + (lane >> 4), ch = lane & 15; const v4u ov = *(const LAS v4u*)(stg + row * 128 + ch * 8);
                    const size_t mrow = rowbase + q0 + 32 * wid + 16 * ps_ + row;
                    const v4u gv = gvs[i];
                    v4u yv; yv.x = pk2(bflo(ov.x) * silu_(bflo(gv.x)), bfhi(ov.x) * silu_(bfhi(gv.x))); yv.y = pk2(bflo(ov.y) * silu_(bflo(gv.y)), bfhi(ov.y) * silu_(bfhi(gv.y)));
                    yv.z = pk2(bflo(ov.z) * silu_(bflo(gv.z)), bfhi(ov.z) * silu_(bfhi(gv.z))); yv.w = pk2(bflo(ov.w) * silu_(bflo(gv.w)), bfhi(ov.w) * silu_(bfhi(gv.w)));
                    if (MODE == 0) *(GAS v4u*)(O + mrow * 4096 + h * 128 + ch * 8) = yv; else if (yv.x == 0x12345678u) *(GAS v4u*)(O + mrow * 4096 + h * 128 + ch * 8) = yv; }
                LDS_WAIT();
            }
            asm volatile("s_waitcnt lgkmcnt(0)\n\ts_barrier" ::: "memory");
#undef ATT_DMA
        }
    }
#undef WAITBAR
}
}

namespace att8 {
constexpr int KN_OFF = 0, KR_OFF = 16384, VT_OFF = 24576, ST_OFF = 49152, WS_OFF = SSD_TAB_OFF;
constexpr float SCALE = 0.07216878364870322f, C2 = SCALE * 1.4426950408889634f, THR = 3.f;
typedef int v8i __attribute__((ext_vector_type(8)));
#define Y8(o, g) __builtin_amdgcn_fmed3f(16.f * (o) * silu_(g), -448.f, 448.f)
#define MFMA8(A, B, C, SA) __builtin_amdgcn_mfma_scale_f32_32x32x64_f8f6f4(A, B, C, 0, 0, 0, SA, 0, 0x7F7F7F7F)
__device__ __forceinline__ v8i rd32(unsigned a0, unsigned a1) { const v4u x = *(const LAS v4u*)(uintptr_t)a0, y = *(const LAS v4u*)(uintptr_t)a1; return (v8i){(int)x.x, (int)x.y, (int)x.z, (int)x.w, (int)y.x, (int)y.y, (int)y.z, (int)y.w}; }

template <int MODE = 0>
__device__ __forceinline__ void attn_phase(Frame& F, const Args& a) {
    unsigned char* ws = a.ws;
    const unsigned char* QN8 = ws + WS_QN8; const unsigned char* QR8 = ws + WS_QR8; const unsigned char* K8 = ws + WS_K8; const unsigned char* VT8 = ws + WS_VT8; const unsigned char* KR8 = ws + WS_KR8;
    const bf16* PROJ = (const bf16*)(ws + WS_PROJ); unsigned char* O8 = ws + WS_O;
    const int wid = F.wave;
    const bool late = wid >= 4;
    const unsigned lds0 = (unsigned)(uintptr_t)F.lds; LAS unsigned char* L = F.lds;
    LAS float* wsf = (LAS float*)(L + WS_OFF) + wid * 64;
    const unsigned kdst0 = (unsigned)__builtin_amdgcn_readfirstlane(lds0 + KN_OFF + wid * 1024), vdst0 = (unsigned)__builtin_amdgcn_readfirstlane(lds0 + VT_OFF + wid * 1024), rdst0 = (unsigned)__builtin_amdgcn_readfirstlane(lds0 + KR_OFF + (wid & 3) * 1024);
#define WAITBAR() asm volatile("s_waitcnt vmcnt(0) lgkmcnt(0)\n\ts_barrier" ::: "memory")
    for (int v = F.vcu; v < 256; v += F.G) {
        const int bh = v >> 2, s4 = v & 3, b = bh >> 5, h = bh & 31; const size_t rowbase = (size_t)b * SEQ;
        for (int ui = 0; ui < 8; ++ui) {
            int lane = F.lane; asm volatile("" : "+v"(lane));
            const int r32 = lane & 31, hi = lane >> 5;
            const unsigned fk = (r32 >> 1) & 7, gk = (r32 >> 2) & 3;
            const unsigned ka00 = r32 * 128 + 16 * ((2 * hi) ^ fk), ka01 = r32 * 128 + 16 * ((2 * hi + 1) ^ fk), ka10 = r32 * 128 + 16 * ((4 + 2 * hi) ^ fk), ka11 = r32 * 128 + 16 * ((5 + 2 * hi) ^ fk);
            const unsigned rv0 = r32 * 64 + 16 * ((2 * hi) ^ gk), rv1 = r32 * 64 + 16 * ((2 * hi + 1) ^ gk);
            unsigned koff, voff, roff;
            { const int row = 8 * wid + (lane >> 3), ch = (lane & 7) ^ ((row >> 1) & 7); koff = (unsigned)((rowbase + row) * 4096 + h * 128 + ch * 16); }
            { const int d = 16 * wid + (lane >> 2), ch = (lane & 3) ^ ((d >> 2) & 3); voff = (unsigned)(((size_t)(b * 32 + h) * 128 + d) * 8192 + ch * 16); }
            { const int key = 16 * (wid & 3) + (lane >> 2), ch = (lane & 3) ^ ((key >> 2) & 3); roff = (unsigned)((rowbase + key) * 64 + ch * 16); }
            const int qb = (ui & 1) ? (31 - (s4 + 4 * (ui >> 1))) : (s4 + 4 * (ui >> 1));
            const int q0 = qb * 256, NT = 4 * qb + 4, qrow = q0 + 32 * wid + r32;
            v8i qf0, qf1, qf2;
            { const unsigned char* qp = QN8 + (rowbase + qrow) * 4096 + h * 128 + hi * 32; const v4u x0 = *(const GAS v4u*)qp, x1 = *(const GAS v4u*)(qp + 16), y0 = *(const GAS v4u*)(qp + 64), y1 = *(const GAS v4u*)(qp + 80);
              const unsigned char* rp = QR8 + (rowbase + qrow) * 2048 + h * 64 + hi * 32; const v4u z0 = *(const GAS v4u*)rp, z1 = *(const GAS v4u*)(rp + 16);
              qf0 = (v8i){(int)x0.x, (int)x0.y, (int)x0.z, (int)x0.w, (int)x1.x, (int)x1.y, (int)x1.z, (int)x1.w}; qf1 = (v8i){(int)y0.x, (int)y0.y, (int)y0.z, (int)y0.w, (int)y1.x, (int)y1.y, (int)y1.z, (int)y1.w};
              qf2 = (v8i){(int)z0.x, (int)z0.y, (int)z0.z, (int)z0.w, (int)z1.x, (int)z1.y, (int)z1.z, (int)z1.w};
              asm volatile("" : "+v"(qf0), "+v"(qf1), "+v"(qf2)); }
            unsigned dks = 0, dvs = 0;
#define ATT_DMA() do { if (MODE == 1) break; \
                glds16(K8, koff, kdst0 + dks * 8192u); glds16(VT8, voff, vdst0 + dvs * 8192u); if (wid < 4) glds16(KR8, roff, rdst0 + dks * 4096u); \
                koff += 64u * 4096u; voff += 64u; roff += 64u * 64u; dks ^= 1u; dvs = (dvs == 2u) ? 0u : dvs + 1u; } while (0)
            float m_reg = -1e30f, l_reg = 0.f; f32x16 o[4] = {};
            ATT_DMA();
            if (late) { WAITBAR(); if (1 < NT) ATT_DMA(); }
            unsigned cks = 0, cvs = 0;
            for (int t = 0; t < NT; ++t) {
                if (!late) { WAITBAR(); if (t + 1 < NT) ATT_DMA(); }
                const bool act = (MODE != 2) && (64 * t <= q0 + 32 * wid + 31);
                v8i pa; float alpha = 1.f;
                if (act) {
                    f32x16 p0 = {}, p1 = {};
                    { const unsigned kb = lds0 + KN_OFF + cks * 8192, rb = lds0 + KR_OFF + cks * 4096;
                      const v8i k00 = rd32(kb + ka00, kb + ka01), k10 = rd32(kb + 4096 + ka00, kb + 4096 + ka01);
                      const v8i k01 = rd32(kb + ka10, kb + ka11), k11 = rd32(kb + 4096 + ka10, kb + 4096 + ka11);
                      const v8i k02 = rd32(rb + rv0, rb + rv1), k12 = rd32(rb + 2048 + rv0, rb + 2048 + rv1);
                      p0 = MFMA8(k00, qf0, p0, 0x7F7F7F7F); p1 = MFMA8(k10, qf0, p1, 0x7F7F7F7F);
                      p0 = MFMA8(k01, qf1, p0, 0x7F7F7F7F); p1 = MFMA8(k11, qf1, p1, 0x7F7F7F7F);
                      p0 = MFMA8(k02, qf2, p0, 0x7F7F7F7F); p1 = MFMA8(k12, qf2, p1, 0x7F7F7F7F); }
                    if (64 * t + 63 > q0 + 32 * wid) { const int dq = qrow - 64 * t - 4 * hi; const float NEG = -__builtin_inff();
#pragma unroll
                        for (int r = 0; r < 16; ++r) { const int c_ = (r & 3) + 8 * (r >> 2); if (c_ > dq) p0[r] = NEG; if (c_ + 32 > dq) p1[r] = NEG; } }
                    float pmax = p0[0];
#pragma unroll
                    for (int r = 1; r < 16; ++r) pmax = fmaxf(pmax, p0[r]);
#pragma unroll
                    for (int r = 0; r < 16; ++r) pmax = fmaxf(pmax, p1[r]);
                    { auto rr = __builtin_amdgcn_permlane32_swap(__float_as_uint(pmax), __float_as_uint(pmax), false, false); pmax = fmaxf(__uint_as_float(rr[0]), __uint_as_float(rr[1])); }
                    if (!__all((pmax - m_reg) * SCALE <= THR)) { const float mn = fmaxf(m_reg, pmax); alpha = __builtin_amdgcn_exp2f((m_reg - mn) * C2); m_reg = mn;
                        if (hi == 0) wsf[r32] = alpha; LDS_WAIT();
#pragma unroll
                        for (int d_ = 0; d_ < 4; ++d_)
#pragma unroll
                            for (int r = 0; r < 16; ++r) o[d_][r] *= wsf[crow(r, hi)]; }
                    const float mnL = 4.0f - m_reg * C2; float ps = 0.f;
#pragma unroll
                    for (int r = 0; r < 16; ++r) { p0[r] = __builtin_amdgcn_exp2f(fmaf(p0[r], C2, mnL)); p1[r] = __builtin_amdgcn_exp2f(fmaf(p1[r], C2, mnL)); ps += p0[r] + p1[r]; }
                    l_reg = l_reg * alpha + ps;
#pragma unroll
                    for (int k = 0; k < 4; ++k) { pa[k] = (int)pg8::pk4_fp8(p0[4 * k], p0[4 * k + 1], p0[4 * k + 2], p0[4 * k + 3]); pa[4 + k] = (int)pg8::pk4_fp8(p1[4 * k], p1[4 * k + 1], p1[4 * k + 2], p1[4 * k + 3]); }
                    SBAR();
                }
                if (late) { WAITBAR(); if (t + 2 < NT) ATT_DMA(); }
                if (act) {
                    const unsigned vb = lds0 + VT_OFF + cvs * 8192;
                    const v8i v0_ = rd32(vb + rv0, vb + rv1), v1_ = rd32(vb + 2048 + rv0, vb + 2048 + rv1), v2_ = rd32(vb + 4096 + rv0, vb + 4096 + rv1), v3_ = rd32(vb + 6144 + rv0, vb + 6144 + rv1);
                    o[0] = MFMA8(pa, v0_, o[0], 0x7B7B7B7B); o[1] = MFMA8(pa, v1_, o[1], 0x7B7B7B7B); o[2] = MFMA8(pa, v2_, o[2], 0x7B7B7B7B); o[3] = MFMA8(pa, v3_, o[3], 0x7B7B7B7B);
                    SBAR();
                }
                cks ^= 1u; cvs = (cvs == 2u) ? 0u : cvs + 1u;
            }
            if (!late) WAITBAR();
            { auto rr = __builtin_amdgcn_permlane32_swap(__float_as_uint(l_reg), __float_as_uint(l_reg), false, false); l_reg = __uint_as_float(rr[0]) + __uint_as_float(rr[1]); }
            if (hi == 0) wsf[32 + r32] = l_reg; LDS_WAIT();
            LAS bf16* stg = (LAS bf16*)(L + ST_OFF + wid * 4096);
#pragma unroll
            for (int ps_ = 0; ps_ < 2; ++ps_) {
                v4u gvs[4];
#pragma unroll
                for (int i = 0; i < 4; ++i) { const int row = i * 4 + (lane >> 4), ch = lane & 15; const size_t mrow = rowbase + q0 + 32 * wid + 16 * ps_ + row; gvs[i] = *(const GAS v4u*)(PROJ + mrow * NP + PC_GATTN + h * 128 + ch * 8); }
#pragma unroll
                for (int r8 = 0; r8 < 8; ++r8) { const int r = 8 * ps_ + r8, orow = crow(r, hi); const float rl = 16.0f * __builtin_amdgcn_rcpf(wsf[32 + orow]);
#pragma unroll
                    for (int dv = 0; dv < 4; ++dv) stg[(orow - 16 * ps_) * 128 + dv * 32 + r32] = (bf16)f2bf(o[dv][r] * rl); }
                LDS_WAIT();
#pragma unroll
                for (int i = 0; i < 4; ++i) { const int row = i * 4 + (lane >> 4), ch = lane & 15; const v4u ov = *(const LAS v4u*)(stg + row * 128 + ch * 8);
                    const size_t mrow = rowbase + q0 + 32 * wid + 16 * ps_ + row;
                    const v4u gv = gvs[i];
                    v2u yv;
                    yv.x = pg8::pk4_fp8(Y8(bflo(ov.x), bflo(gv.x)), Y8(bfhi(ov.x), bfhi(gv.x)), Y8(bflo(ov.y), bflo(gv.y)), Y8(bfhi(ov.y), bfhi(gv.y)));
                    yv.y = pg8::pk4_fp8(Y8(bflo(ov.z), bflo(gv.z)), Y8(bfhi(ov.z), bfhi(gv.z)), Y8(bflo(ov.w), bflo(gv.w)), Y8(bfhi(ov.w), bfhi(gv.w)));
                    if (MODE == 0) *(GAS v2u*)(O8 + mrow * 4096 + h * 128 + ch * 8) = yv; else if (yv.x == 0x12345678u) *(GAS v2u*)(O8 + mrow * 4096 + h * 128 + ch * 8) = yv; }
                LDS_WAIT();
            }
            asm volatile("s_waitcnt lgkmcnt(0)\n\ts_barrier" ::: "memory");
#undef ATT_DMA
        }
    }
#undef WAITBAR
}
#undef MFMA8
}

__device__ __forceinline__ void p6_thin(Frame& F, const Args& a, bool dry = false) {
    unsigned char* ws = a.ws; const bf16* PROJ = (const bf16*)(ws + WS_PROJ); bf16* XBC = (bf16*)(ws + WS_XBC);
    const int gw = F.vcu * NWAVES + F.wave, NGW = F.G * NWAVES;
    LAS float* scr = (LAS float*)(F.lds + RING_OFF + F.wave * 16384);
    constexpr int I_BS = (D_SSM / 64) * (DM / 32), I_BA = (DM / 64) * (DM / 32), I_OUT = I_BA;
    auto dec = [&](int it) -> TItem {
        int r = it;
        if (r < I_BS) return TItem{a.w_bs, ws + WS_WBS, nullptr, D_SSM, DM, D_SSM * 2, DM / 32, r, 4, 1.0f, false}; r -= I_BS;
        if (r < I_BA) return TItem{a.w_ba, ws + WS_WBA, nullptr, DM, DM, DM, DM / 32, r, 4, 64.0f, true}; r -= I_BA;
        return TItem{a.w_out, ws + WS_WOUT, nullptr, DM, DM, DM * 2, DM / 32, r, 4, 1.0f, false}; };
    transpose_stream(dec, I_BS + I_BA + I_OUT, gw, NGW, F.lane, scr);
    const int g0 = (gw * 4) & 7;
    f32x4 wq[4][4];
#pragma unroll
    for (int u = 0; u < 4; ++u)
#pragma unroll
        for (int q = 0; q < 4; ++q) wq[u][q] = *(const GAS f32x4*)(a.ssm_norm_w + (g0 + u) * 1024 + F.lane * 16 + 4 * q);
    for (int it0 = gw * 4; it0 < M * NG; it0 += NGW * 4) {
        v4u y0[4], y1[4], z0[4], z1[4];
#pragma unroll
        for (int u = 0; u < 4; ++u) { const int it = it0 + u, m = it >> 3, g = it & 7; const bf16* yp = XBC + (size_t)m * D_CONV + g * 1024 + F.lane * 16; const bf16* zp = PROJ + (size_t)m * NP + PC_Z + g * 1024 + F.lane * 16;
            y0[u] = *(const GAS v4u*)yp; y1[u] = *(const GAS v4u*)(yp + 8); z0[u] = *(const GAS v4u*)zp; z1[u] = *(const GAS v4u*)(zp + 8); }
#pragma unroll
        for (int u = 0; u < 4; ++u) { const int it = it0 + u, m = it >> 3, g = it & 7; bf16* yp = XBC + (size_t)m * D_CONV + g * 1024 + F.lane * 16;
            float v[16]; float s = 0.f;
#pragma unroll
            for (int j = 0; j < 4; ++j) { v[2 * j] = bflo(y0[u][j]) * silu_(bflo(z0[u][j])); v[2 * j + 1] = bfhi(y0[u][j]) * silu_(bfhi(z0[u][j])); v[8 + 2 * j] = bflo(y1[u][j]) * silu_(bflo(z1[u][j])); v[8 + 2 * j + 1] = bfhi(y1[u][j]) * silu_(bfhi(z1[u][j])); }
#pragma unroll
            for (int j = 0; j < 16; ++j) s += v[j] * v[j];
            const float rstd = 1.0f / sqrtf(wave_sum(s) * (1.f / 1024.f) + EPS);
            v4u o0, o1;
#pragma unroll
            for (int j = 0; j < 4; ++j) { o0[j] = pk2(v[2 * j] * rstd * wq[u][j >> 1][(2 * j) & 3], v[2 * j + 1] * rstd * wq[u][j >> 1][(2 * j + 1) & 3]); o1[j] = pk2(v[8 + 2 * j] * rstd * wq[u][2 + (j >> 1)][(2 * j) & 3], v[8 + 2 * j + 1] * rstd * wq[u][2 + (j >> 1)][(2 * j + 1) & 3]); }
            if (!dry) { *(GAS v4u*)yp = o0; *(GAS v4u*)(yp + 8) = o1; } }
    }
}
__device__ __forceinline__ void p9_final(Frame& F, const Args& a, bool dry = false) {
    const int gw = F.vcu * NWAVES + F.wave, NGW = F.G * NWAVES; const bf16* H = (const bf16*)(a.ws + WS_H16);
    f32x4 w0[8], w1[8];
    { const GAS f32x4* wr = (const GAS f32x4*)a.norm_final_w;
#pragma unroll
      for (int j = 0; j < 8; ++j) { const int c4 = 2 * (F.lane + 64 * j); w0[j] = wr[c4]; w1[j] = wr[c4 + 1]; } }
    v4u hv[8];
    if (gw < M) { const GAS v4u* hr = (const GAS v4u*)(H + (size_t)gw * DM) + F.lane;
#pragma unroll
        for (int j = 0; j < 8; ++j) hv[j] = hr[64 * j]; }
    for (int m = gw; m < M; m += NGW) {
        v4u hn[8]; const int mn = (m + NGW < M) ? m + NGW : m;
        { const GAS v4u* hr = (const GAS v4u*)(H + (size_t)mn * DM) + F.lane;
#pragma unroll
          for (int j = 0; j < 8; ++j) hn[j] = hr[64 * j]; }
        float s = 0.f;
#pragma unroll
        for (int j = 0; j < 8; ++j)
#pragma unroll
            for (int e = 0; e < 4; ++e) { const float lo = bflo(hv[j][e]), hi_ = bfhi(hv[j][e]); s += lo * lo + hi_ * hi_; }
        const float rstd = 1.0f / sqrtf(wave_sum(s) * (1.f / DM) + EPS);
        GAS f32x4* orow = (GAS f32x4*)(a.out + (size_t)m * DM);
#pragma unroll
        for (int j = 0; j < 8; ++j) { const int c4 = 2 * (F.lane + 64 * j);
            f32x4 o0, o1; o0.x = bflo(hv[j].x) * rstd * w0[j].x; o0.y = bfhi(hv[j].x) * rstd * w0[j].y; o0.z = bflo(hv[j].y) * rstd * w0[j].z; o0.w = bfhi(hv[j].y) * rstd * w0[j].w;
            o1.x = bflo(hv[j].z) * rstd * w1[j].x; o1.y = bfhi(hv[j].z) * rstd * w1[j].y; o1.z = bflo(hv[j].w) * rstd * w1[j].z; o1.w = bfhi(hv[j].w) * rstd * w1[j].w;
            if (!dry) { orow[c4] = o0; orow[c4 + 1] = o1; } }
#pragma unroll
        for (int j = 0; j < 8; ++j) hv[j] = hn[j];
    }
}

constexpr int NPHASE = 10;
__global__ void __launch_bounds__(NWAVES * 64, 2) mk_fwd(Args args) {
    extern __shared__ __attribute__((aligned(16))) unsigned char lds[];
    Frame F;
    F.lds = (LAS unsigned char*)lds;
    F.MISC = (volatile LAS unsigned*)(F.lds + MISC_OFF);
    F.tid = threadIdx.x; F.lane = F.tid & 63; F.wave = __builtin_amdgcn_readfirstlane(F.tid >> 6);
    F.G = gridDim.x; { const int bx = blockIdx.x; F.vcu = (F.G % 8 == 0) ? (bx % 8) * (F.G / 8) + bx / 8 : bx; }
    unsigned char* ws = args.ws;
    F.ctl = (gu32*)(ws + WS_CTL);
    for (int u = F.tid; u < 512 / 4; u += NWAVES * 64) ((LAS unsigned*)(F.lds + LDSCTL_OFF))[u] = 0u;
    __syncthreads();
    const int lo = args.ph_lo, hi = args.ph_hi;
    const bool multi = (hi - lo) > 1;
    XcdBarrier bar; bar.bar = (unsigned*)(F.ctl + CW_BAR); bar.x = 0; bar.st = nullptr;
    if (multi) bar = xcd_barrier_post((unsigned*)(F.ctl + CW_BAR), F.MISC + 8);
#ifndef PH_MASK
#define PH_MASK 0x3ff
#endif
#define IN(k) (((PH_MASK >> (k)) & 1) && lo <= (k) && (k) < hi)
#define BOTH(k) (IN(k) && IN((k) + 1))
#define GRID_BAR() xcd_barrier(bar)
    typedef pg8::bf16_t b16;
#ifndef PROBE_DUP
#define PROBE_DUP -1
#endif
#ifndef P1_SP2
#define P1_SP2 true
#endif
#define DUP(k, BODY) do { BODY; if (PROBE_DUP == (k)) { GRID_BAR(); BODY; } } while (0)
#define P1_BODY do { \
        { pg8::Gemm g{(const b16*)(ws + WS_U), (const b16*)(ws + WS_WIN), M, N16, DM, DM, DM}; pg8::StaticOrder S; S.init(M, N16, F.G, (int)blockIdx.x); \
          pg8::EpiProj E{(b16*)(ws + WS_PROJ), NP, (float*)(ws + WS_DT32), GC_DT / 256}; \
          pg8::gemm_phase<pg8::EpiProj, pg8::StaticOrder, 0, P1_SP2>(F.lds + RING_OFF, g, S, E); } \
        { pg8::Gemm g{(const b16*)(ws + WS_U8), (const b16*)(ws + WS_WIN8), M, N8, DM / 2, DM / 2, DM / 2, 0x7F7F7F7F, 0x79797979};     \
          const int r16_ = ((M / 256) * (N16 / 256)) % F.G;                        \
          pg8::StaticOrder S; S.init(M, N8, F.G, (int)((blockIdx.x + F.G - r16_) % F.G)); \
          pg8::EpiProj8 E{(b16*)(ws + WS_PROJ) + PC_A0, NP, ws + WS_CQ8, ws + WS_KV8, (PC_CQ - PC_A0) / 256, (PC_KV - PC_A0) / 256}; \
          pg8::gemm_phase<pg8::EpiProj8, pg8::StaticOrder, 0, true, true>(F.lds + RING_OFF, g, S, E); } } while (0)
#define P3_BODY do { \
          \
        { pg8::Gemm g{(const b16*)(ws + WS_CQ8), (const b16*)(ws + WS_WUQ), M, 6144, Q_LORA / 2, Q_LORA / 2, Q_LORA / 2, 0x7F7F7F7F, 0x7A7A7A7A}; pg8::StaticOrder S; S.init(M, 6144, F.G, (int)blockIdx.x); \
          pg8::EpiQ8 E{ws + WS_QN8, ws + WS_QR8, (const float*)(ws + WS_RSTDQ), (const float*)(ws + WS_COS), (const float*)(ws + WS_SIN)}; \
          pg8::gemm_phase<pg8::EpiQ8, pg8::StaticOrder, 0, true, true>(F.lds + RING_OFF, g, S, E); } \
        { pg8::Gemm g{(const b16*)(ws + WS_KV8), (const b16*)(ws + WS_WUKV), M, 4096, KV_LORA / 2, KV_LORA / 2, KV_LORA / 2, 0x7F7F7F7F, 0x7A7A7A7A}; pg8::StaticOrder S; S.init(M, 4096, F.G, (int)blockIdx.x); \
          pg8::EpiK8 E{ws + WS_K8, (const float*)(ws + WS_RSTDKV)}; \
          pg8::gemm_phase<pg8::EpiK8, pg8::StaticOrder, 0, true, true>(F.lds + RING_OFF, g, S, E); } \
        { pg8::Gemm g{(const b16*)(ws + WS_WUKV + (size_t)4096 * KV_LORA), (const b16*)(ws + WS_KV8), 4096, M, KV_LORA / 2, KV_LORA / 2, KV_LORA / 2, 0x7A7A7A7A, 0x7F7F7F7F}; pg8::StaticOrder S; S.init(4096, M, F.G, (int)blockIdx.x); \
          pg8::EpiVT8 E{ws + WS_VT8, (const float*)(ws + WS_RSTDKV)}; \
          pg8::gemm_phase<pg8::EpiVT8, pg8::StaticOrder, 0, true, true>(F.lds + RING_OFF, g, S, E); } } while (0)
#define P7_BODY do { \
        { pg8::Gemm g{(const b16*)(ws + WS_O), (const b16*)(ws + WS_WBA), M, DM, DM / 2, DM / 2, DM / 2, 0x7B7B7B7B, 0x79797979};     \
          pg8::StaticOrder S; S.init(M, DM, F.G, (int)blockIdx.x); \
          pg8::EpiGate<false> E{(b16*)(ws + WS_MERGED), (const b16*)(ws + WS_PROJ) + PC_GATT2, NP}; \
          pg8::gemm_phase<pg8::EpiGate<false>, pg8::StaticOrder, 0, true, true>(F.lds + RING_OFF, g, S, E); } \
        { pg8::Gemm g{(const b16*)(ws + WS_XBC), (const b16*)(ws + WS_WBS), M, DM, D_SSM, D_CONV, D_SSM}; pg8::StaticOrder S; S.init(M, DM, F.G, (int)blockIdx.x); \
          pg8::EpiGate<true> E{(b16*)(ws + WS_MERGED), (const b16*)(ws + WS_PROJ) + PC_GSSM, NP}; \
          pg8::gemm_phase<pg8::EpiGate<true>, pg8::StaticOrder>(F.lds + RING_OFF, g, S, E); } } while (0)
#define P8_BODY do { pg8::Gemm g{(const b16*)(ws + WS_MERGED), (const b16*)(ws + WS_WOUT), M, DM, DM, DM, DM}; pg8::StaticOrder S; S.init(M, DM, F.G, (int)blockIdx.x); \
        pg8::EpiOut E{(b16*)(ws + WS_H16), args.x}; \
        pg8::gemm_phase<pg8::EpiOut, pg8::StaticOrder>(F.lds + RING_OFF, g, S, E); } while (0)
    if (IN(0)) { DUP(0, p0_prologue(F, args)); if (BOTH(0)) GRID_BAR(); }
#define P1_PROBE(PV) do { pg8::Gemm g{(const b16*)(ws + WS_U), (const b16*)(ws + WS_WIN), M, N16, DM, DM, DM}; pg8::StaticOrder S; S.init(M, N16, F.G, (int)blockIdx.x); \
        pg8::EpiProj E{(b16*)(ws + WS_PROJ), NP, (float*)(ws + WS_DT32), GC_DT / 256}; \
        pg8::gemm_phase<pg8::EpiProj, pg8::StaticOrder, PV>(F.lds + RING_OFF, g, S, E); } while (0)
    if (IN(1)) { if (PROBE_DUP == 11) { P1_PROBE(1); GRID_BAR(); } if (PROBE_DUP == 12) { P1_PROBE(2); GRID_BAR(); } if (PROBE_DUP == 13) { P1_PROBE(3); GRID_BAR(); } DUP(1, P1_BODY); if (BOTH(1)) GRID_BAR(); }
    if (IN(2)) { DUP(2, p2_thin(F, args)); if (BOTH(2)) GRID_BAR(); if (PROBE_DUP == 50) { for (int i_ = 0; i_ < 20; ++i_) GRID_BAR(); } }
    if (IN(3)) { DUP(3, P3_BODY);   }
    if (IN(4)) { if (PROBE_DUP == 41) { ssd::ssd_phase<0>(F, args, true); GRID_BAR(); } if (PROBE_DUP == 42) { ssd::ssd_phase<2>(F, args, true); GRID_BAR(); } if (PROBE_DUP == 43) { ssd::ssd_phase<3>(F, args, true); GRID_BAR(); } if (PROBE_DUP == 44) { ssd::ssd_phase<4>(F, args, true); GRID_BAR(); }
        ssd::ssd_phase<0>(F, args); if (BOTH(4)) GRID_BAR(); }
    if (IN(5)) { if (PROBE_DUP == 31) { att::attn_phase<1>(F, args); GRID_BAR(); } if (PROBE_DUP == 32) { att::attn_phase<2>(F, args); GRID_BAR(); } if (PROBE_DUP == 33) { att::attn_phase<3>(F, args); GRID_BAR(); }
        if (PROBE_DUP == 61) { att8::attn_phase<1>(F, args); GRID_BAR(); }
        DUP(5, att8::attn_phase<0>(F, args)); if (BOTH(5)) GRID_BAR(); }
    if (IN(6)) { if (PROBE_DUP == 6) { p6_thin(F, args, true); GRID_BAR(); } p6_thin(F, args); if (BOTH(6)) GRID_BAR(); }
    if (IN(7)) { DUP(7, P7_BODY); if (BOTH(7)) GRID_BAR(); }
    if (IN(8)) { DUP(8, P8_BODY); if (BOTH(8)) GRID_BAR(); }
    if (IN(9)) { if (PROBE_DUP == 9) { p9_final(F, args, true); GRID_BAR(); } p9_final(F, args); }
    if (PROBE_DUP == 20 && xb_xcc_id() != (blockIdx.x & 7u) && F.tid == 0) args.out[blockIdx.x] = __builtin_nanf("");
#undef IN
#undef BOTH
#undef GRID_BAR
}

#if MK_DEBUG
constexpr size_t WS_DBG = WS_END;
constexpr int DBG_NROW = 64;
__device__ __forceinline__ unsigned dh(unsigned x) { x ^= x >> 16; x *= 0x7feb352dU; x ^= x >> 15; x *= 0x846ca68bU; x ^= x >> 16; return x; }
__device__ __forceinline__ void chk_put(unsigned* w, double got, double ref, double flr, double tol) { double e = fabs(got - ref) / (tol * (fabs(ref) + flr)); float f = (float)e; if (!(f == f) || !(got == got)) f = 1e30f; atomicMax(w, __float_as_uint(f)); }
__device__ __forceinline__ int dbg_row(int i) { const int special[8] = {0, 1, 2, 3, 127, 128, 8191, 8192}; return i < 8 ? special[i] : (i < 12 ? 16383 - (i - 8) * 129 : (int)(dh(i * 7919u + 13u) % M)); }

__device__ __forceinline__ double fp8d(unsigned char v) { const int sg = v >> 7, e = (v >> 3) & 15, m = v & 7; const double x = (e == 0) ? m * 0.001953125 : (1.0 + m * 0.125) * (double)(1 << e) * 0.0078125; return sg ? -x : x; }
__device__ __forceinline__ int vtpos(int t) { const int k = t & 63; return (t & ~63) + 32 * ((k >> 2) & 1) + 16 * (k >> 5) + 4 * ((k >> 3) & 3) + (k & 3); }
__global__ void dbg_save_rows(Args a) {
    const int i = blockIdx.x, m = dbg_row(i); const bf16* src = (const bf16*)(a.ws + WS_XBC) + (size_t)m * D_CONV; bf16* dst = (bf16*)(a.ws + WS_DBG) + (size_t)i * D_CONV;
    for (int c = threadIdx.x; c < D_CONV; c += blockDim.x) dst[c] = src[c];
}
__device__ double dbg_conv(const Args& a, int m, int c) {
    const bf16* PROJ = (const bf16*)(a.ws + WS_PROJ); const int t = m & (SEQ - 1); double acc = a.conv_b[c];
    for (int k = 0; k < 4; ++k) { const int tt = t - 3 + k; if (tt >= 0) acc += (double)a.conv_w[k * D_CONV + c] * (double)bf2f(PROJ[(size_t)(m - 3 + k) * NP + PC_XBC + c]); }
    return acc / (1.0 + exp(-acc));
}
__global__ void __launch_bounds__(256) dbg_chk(Args a, int stage) {
    unsigned char* ws = a.ws; unsigned* ew = (unsigned*)(ws + WS_CTL) + CW_CHK + stage;
    const int gid = blockIdx.x * blockDim.x + threadIdx.x, tid = threadIdx.x;
    const bf16* PROJ = (const bf16*)(ws + WS_PROJ);
    __shared__ float sh[8192]; __shared__ double red[256];
    if (stage == 0) {
        if (gid < 2048) { const int m = dbg_row(gid & 63), k = dh(gid) % DM; double s = 0; for (int j = 0; j < DM; ++j) { double v = a.x[(size_t)m * DM + j]; s += v * v; }
            const double ref = a.x[(size_t)m * DM + k] / sqrt(s / DM + 1e-6) * a.norm_in_w[k]; chk_put(ew, bf2f(((const bf16*)(ws + WS_U))[(size_t)m * DM + k]), ref, 0.05, 0.006); }
        else if (gid < 4096) { const int n = (gid < 2200) ? (N16 - 1 - (gid - 2048)) : dh(gid) % N16, k = dh(gid * 3 + 1) % DM; const int sc = SrcIn16()(n); const double ref = sc >= 0 ? a.w_in[(size_t)k * D_IN + sc] : 0.0;
            chk_put(ew, bf2f(((const bf16*)(ws + WS_WIN))[(size_t)n * DM + k]), ref, 1e-3, 0.006); }
        else if (gid < 6144) { const int n = (gid < 4300) ? (N8 - 1 - (gid - 4096)) : dh(gid) % N8, k = dh(gid * 3 + 1) % DM; const int sc = SrcIn8()(n); const double ref = sc >= 0 ? a.w_in[(size_t)k * D_IN + sc] : 0.0;
            chk_put(ew, fp8d((ws + WS_WIN8)[(size_t)n * DM + k]) / 64.0, ref, 1e-3, 0.08);
            const int m = dbg_row(gid & 63); chk_put(ew, fp8d((ws + WS_U8)[(size_t)m * DM + k]), bf2f(((const bf16*)(ws + WS_U))[(size_t)m * DM + k]), 0.05, 0.08); }
        else if (gid < 8192) { const int n = dh(gid) % 6144, k = dh(gid * 3 + 1) % Q_LORA; const int sc = SrcUq()(n); chk_put(ew, fp8d((ws + WS_WUQ)[(size_t)n * Q_LORA + k]) / 32.0, (double)a.w_uq[(size_t)k * 6144 + sc] * a.q_norm_w[k], 2e-3, 0.08); }
        else if (gid < 10240) { const int n = dh(gid) % 8192, k = dh(gid * 3 + 1) % KV_LORA; chk_put(ew, fp8d((ws + WS_WUKV)[(size_t)n * KV_LORA + k]) / 32.0, (double)a.w_ukv[(size_t)k * 8192 + SrcUkv()(n)] * a.kv_norm_w[k], 2e-3, 0.08); }
        else if (gid < 14336) { const int t = (gid < 10400) ? (gid - 10240) : 1 + dh(gid) % (SEQ - 1), i = dh(gid * 5 + 2) & 31; const float* C = (const float*)(ws + WS_COS); const float* S = (const float*)(ws + WS_SIN);
            double f = 1.0; for (int k = 0; k < i; ++k) f *= 0.74989420933245582730; double cf = 1, sf = 0, term = 1; for (int k = 1; k < 24; ++k) { term *= f / k; const int q = k & 3; if (q == 1) sf += term; else if (q == 2) cf -= term; else if (q == 3) sf -= term; else cf += term; }
            if (t == 0) { chk_put(ew, C[i], 1.0, 1.0, 3e-4); chk_put(ew, S[i], 0.0, 1.0, 3e-4); } else { const double c0 = C[(t - 1) * 32 + i], s0 = S[(t - 1) * 32 + i]; chk_put(ew, C[t * 32 + i], c0 * cf - s0 * sf, 1.0, 3e-4); chk_put(ew, S[t * 32 + i], s0 * cf + c0 * sf, 1.0, 3e-4); } }
    } else if (stage == 1) {
        if (gid < 4096) { const int m = dbg_row(gid & 63); int n; const int sel = gid >> 6; if (sel < 16) n = GC_DT - 1 - sel * 50; else n = dh(gid) % GC_DT;
            const bf16* u = (const bf16*)(ws + WS_U) + (size_t)m * DM; const bf16* w = (const bf16*)(ws + WS_WIN) + (size_t)n * DM; double s = 0; for (int k = 0; k < DM; ++k) s += (double)bf2f(u[k]) * (double)bf2f(w[k]);
            chk_put(ew, bf2f(PROJ[(size_t)m * NP + n]), s, 0.25, 0.01); }
        else if (gid < 8192) { const int m = dbg_row(gid & 63); int n; const int sel = (gid - 4096) >> 6; if (sel < 16) n = N8 - 1 - sel * 50; else n = dh(gid) % N8;
            const unsigned char* u = ws + WS_U8 + (size_t)m * DM; const unsigned char* w = ws + WS_WIN8 + (size_t)n * DM; double s = 0; for (int k = 0; k < DM; ++k) s += fp8d(u[k]) * fp8d(w[k]);
            chk_put(ew, bf2f(PROJ[(size_t)m * NP + PC_A0 + n]), s / 64.0, 0.25, 0.01);
            const int kq = dh(gid * 7 + 3) & 1023, kk = dh(gid * 11 + 5) & 511;
            chk_put(ew, fp8d((ws + WS_CQ8)[(size_t)m * 1024 + kq]), bf2f(PROJ[(size_t)m * NP + PC_CQ + kq]), 0.05, 0.08); chk_put(ew, fp8d((ws + WS_KV8)[(size_t)m * 512 + kk]), bf2f(PROJ[(size_t)m * NP + PC_KV + kk]), 0.05, 0.08); }
        else if (gid < 8192 + 2048) { const int m = dbg_row(gid & 63), j = dh(gid) & 127; const bf16* u = (const bf16*)(ws + WS_U) + (size_t)m * DM; const bf16* w = (const bf16*)(ws + WS_WIN) + (size_t)(GC_DT + j) * DM; double s = 0; for (int k = 0; k < DM; ++k) s += (double)bf2f(u[k]) * (double)bf2f(w[k]);
            chk_put(ew, ((const float*)(ws + WS_DT32))[(size_t)m * 128 + j], s, 1.0, 1e-3); }
    } else if (stage == 2) {
        if (gid < 8192) { const int m = dbg_row(gid & 63), c = (gid < 4096) ? dh(gid) % D_CONV : (D_CONV - 1 - (gid & 1023)); chk_put(ew, bf2f(((const bf16*)(ws + WS_XBC))[(size_t)m * D_CONV + c]), dbg_conv(a, m, c), 0.1, 0.01); }
        else if (gid < 8192 + 64) { const int m = dbg_row(gid & 63); double sq = 0, sk = 0; for (int k = 0; k < Q_LORA; ++k) { double v = bf2f(PROJ[(size_t)m * NP + PC_CQ + k]); sq += v * v; } for (int k = 0; k < KV_LORA; ++k) { double v = bf2f(PROJ[(size_t)m * NP + PC_KV + k]); sk += v * v; }
            chk_put(ew, ((const float*)(ws + WS_RSTDQ))[m], 1.0 / sqrt(sq / Q_LORA + 1e-6), 0.0, 1e-4); chk_put(ew, ((const float*)(ws + WS_RSTDKV))[m], 1.0 / sqrt(sk / KV_LORA + 1e-6), 0.0, 1e-4); }
        else if (gid < 8192 + 64 + 2048) { const int m = dbg_row(gid & 63), i = (gid >> 6) & 31, t = m & (SEQ - 1); const double x1 = bf2f(PROJ[(size_t)m * NP + PC_KV + 512 + i]), x2 = bf2f(PROJ[(size_t)m * NP + PC_KV + 544 + i]);
            const double c = ((const float*)(ws + WS_COS))[t * 32 + i], sn = ((const float*)(ws + WS_SIN))[t * 32 + i]; const bf16* kr = (const bf16*)(ws + WS_KROPE) + (size_t)m * 64;
            chk_put(ew, bf2f(kr[2 * i]), x1 * c - x2 * sn, 0.25, 0.01); chk_put(ew, bf2f(kr[2 * i + 1]), x2 * c + x1 * sn, 0.25, 0.01);
            const unsigned char* k8 = ws + WS_KR8 + (size_t)m * 64; chk_put(ew, fp8d(k8[2 * i]), x1 * c - x2 * sn, 0.1, 0.08); chk_put(ew, fp8d(k8[2 * i + 1]), x2 * c + x1 * sn, 0.1, 0.08); }
    } else if (stage == 3) {
        const unsigned char* CQ = ws + WS_CQ8; const unsigned char* CK = ws + WS_KV8; const unsigned char* WQ = ws + WS_WUQ; const unsigned char* WK = ws + WS_WUKV;
        if (gid < 4096) { const int m = dbg_row(gid & 63), n = dh(gid) % 4096; double s = 0; for (int k = 0; k < Q_LORA; ++k) s += fp8d(CQ[(size_t)m * Q_LORA + k]) * fp8d(WQ[(size_t)n * Q_LORA + k]);
            chk_put(ew, fp8d((ws + WS_QN8)[(size_t)m * 4096 + n]), s / 32.0 * ((const float*)(ws + WS_RSTDQ))[m], 0.1, 0.08); }
        else if (gid < 8192) { const int m = dbg_row(gid & 63), pr = dh(gid) % 1024, t = m & (SEQ - 1), i = pr & 31; const int n1 = 4096 + 2 * pr, n2 = n1 + 1; double s1 = 0, s2 = 0;
            for (int k = 0; k < Q_LORA; ++k) { const double av = fp8d(CQ[(size_t)m * Q_LORA + k]); s1 += av * fp8d(WQ[(size_t)n1 * Q_LORA + k]); s2 += av * fp8d(WQ[(size_t)n2 * Q_LORA + k]); }
            const double rs = ((const float*)(ws + WS_RSTDQ))[m] / 32.0; s1 *= rs; s2 *= rs; const double c = ((const float*)(ws + WS_COS))[t * 32 + i], sn = ((const float*)(ws + WS_SIN))[t * 32 + i];
            const unsigned char* qr = ws + WS_QR8 + (size_t)m * 2048; chk_put(ew, fp8d(qr[2 * pr]), s1 * c - s2 * sn, 0.1, 0.08); chk_put(ew, fp8d(qr[2 * pr + 1]), s2 * c + s1 * sn, 0.1, 0.08); }
        else if (gid < 12288) { const int m = dbg_row(gid & 63), n = dh(gid) % 4096; double s = 0; for (int k = 0; k < KV_LORA; ++k) s += fp8d(CK[(size_t)m * KV_LORA + k]) * fp8d(WK[(size_t)n * KV_LORA + k]);
            chk_put(ew, fp8d((ws + WS_K8)[(size_t)m * 4096 + n]), s / 32.0 * ((const float*)(ws + WS_RSTDKV))[m], 0.1, 0.08); }
        else if (gid < 16384) { const int m = dbg_row(gid & 63), r = dh(gid) % 4096, bb = m >> 13, t = m & (SEQ - 1); double s = 0; for (int k = 0; k < KV_LORA; ++k) s += fp8d(CK[(size_t)m * KV_LORA + k]) * fp8d(WK[(size_t)(4096 + r) * KV_LORA + k]);
            chk_put(ew, fp8d((ws + WS_VT8)[(size_t)(bb * 4096 + r) * 8192 + vtpos(t)]), s / 32.0 * ((const float*)(ws + WS_RSTDKV))[m], 0.1, 0.08); }
    } else if (stage == 4) {
        const int si = blockIdx.x; if (si >= 96) return; const int tl[12] = {0, 1, 127, 128, 129, 255, 256, 1000, 4095, 4096, 8190, 8191};
        const int b = si & 1, hh = dh(si * 31 + 5) & 127, t = (si < 24) ? tl[si >> 1] : (int)(dh(si * 17 + 3) % SEQ), p = dh(si * 13 + 1) & 63, g = hh >> 4;
        const bf16* XBC = (const bf16*)(ws + WS_XBC); const float* DT32 = (const float*)(ws + WS_DT32); const double A = -exp((double)a.a_log[hh]);
        if (tid == 0) { double d = 0; for (int s = t; s >= 0; --s) { sh[s] = (float)d; const double dt = (double)DT32[((size_t)b * SEQ + s) * 128 + hh]; d += dt * A; } }
        __syncthreads();
        const size_t mt = (size_t)b * SEQ + t; double acc = 0;
        for (int s = tid; s <= t; s += 256) { const size_t ms = (size_t)b * SEQ + s; double cb = 0; for (int n = 0; n < 128; ++n) cb += (double)bf2f(XBC[mt * D_CONV + D_SSM + 1024 + g * 128 + n]) * (double)bf2f(XBC[ms * D_CONV + D_SSM + g * 128 + n]);
            const double dt = (double)DT32[ms * 128 + hh];
            acc += cb * exp((double)sh[s]) * dt * dbg_conv(a, (int)ms, hh * 64 + p); }
        red[tid] = acc; __syncthreads(); for (int o = 128; o > 0; o >>= 1) { if (tid < o) red[tid] += red[tid + o]; __syncthreads(); }
        if (tid == 0) { const double ref = red[0] + (double)a.d_skip[hh] * dbg_conv(a, (int)mt, hh * 64 + p); chk_put(ew, bf2f(XBC[mt * D_CONV + hh * 64 + p]), ref, 0.3, 0.03); }
    } else if (stage == 5) {
        const int si = blockIdx.x; if (si >= 96) return; const int tl[12] = {0, 1, 31, 32, 63, 64, 255, 256, 257, 4095, 4096, 8191};
        const int b = si & 1, h = dh(si * 31 + 5) & 31, t = (si < 24) ? tl[si >> 1] : (int)(dh(si * 17 + 3) % SEQ), d = dh(si * 13 + 1) & 127;
        const unsigned char* QN = ws + WS_QN8; const unsigned char* QR = ws + WS_QR8; const unsigned char* K8 = ws + WS_K8; const unsigned char* KR = ws + WS_KR8; const unsigned char* VT = ws + WS_VT8;
        const size_t mt = (size_t)b * SEQ + t; float mx = -1e30f;
        for (int j = tid; j <= t; j += 256) { const size_t mj = (size_t)b * SEQ + j; double s = 0; for (int k = 0; k < 128; ++k) s += fp8d(QN[mt * 4096 + h * 128 + k]) * fp8d(K8[mj * 4096 + h * 128 + k]);
            for (int k = 0; k < 64; ++k) s += fp8d(QR[mt * 2048 + h * 64 + k]) * fp8d(KR[mj * 64 + k]); sh[j] = (float)(s * 0.07216878364870322); mx = fmaxf(mx, sh[j]); }
        red[tid] = mx; __syncthreads(); for (int o = 128; o > 0; o >>= 1) { if (tid < o) red[tid] = fmax(red[tid], red[tid + o]); __syncthreads(); } const double gm = red[0]; __syncthreads();
        double l = 0, ov = 0; for (int j = tid; j <= t; j += 256) { const double pj = exp((double)sh[j] - gm); l += pj; ov += pj * fp8d(VT[(size_t)(b * 4096 + h * 128 + d) * 8192 + vtpos(j)]); }
        red[tid] = l; __syncthreads(); for (int o = 128; o > 0; o >>= 1) { if (tid < o) red[tid] += red[tid + o]; __syncthreads(); } const double L = red[0]; __syncthreads();
        red[tid] = ov; __syncthreads(); for (int o = 128; o > 0; o >>= 1) { if (tid < o) red[tid] += red[tid + o]; __syncthreads(); }
        if (tid == 0) { const double gz = bf2f(PROJ[mt * NP + PC_GATTN + h * 128 + d]); const double ref = red[0] / L * gz / (1.0 + exp(-gz)); chk_put(ew, fp8d((ws + WS_O)[mt * 4096 + h * 128 + d]) / 16.0, ref, 0.05, 0.2); }
    } else if (stage == 6) {
        if (gid < 4096) { const int i = gid & 63, m = dbg_row(i), g = (gid >> 6) & 7, c = g * 1024 + (dh(gid) & 1023); const bf16* yp = (const bf16*)(ws + WS_DBG) + (size_t)i * D_CONV; double s = 0, vc = 0;
            for (int k = 0; k < 1024; ++k) { const double z = bf2f(PROJ[(size_t)m * NP + PC_Z + g * 1024 + k]); const double v = (double)bf2f(yp[g * 1024 + k]) * z / (1.0 + exp(-z)); s += v * v; if (g * 1024 + k == c) vc = v; }
            chk_put(ew, bf2f(((const bf16*)(ws + WS_XBC))[(size_t)m * D_CONV + c]), vc / sqrt(s / 1024 + 1e-6) * a.ssm_norm_w[c], 0.25, 0.01); }
        else if (gid < 8192) { const int n = dh(gid) % DM, k = dh(gid * 3 + 1) % D_SSM; chk_put(ew, bf2f(((const bf16*)(ws + WS_WBS))[(size_t)n * D_SSM + k]), a.w_bs[(size_t)k * DM + n], 1e-3, 0.006); }
        else if (gid < 12288) { const int n = dh(gid) % DM, k = dh(gid * 3 + 1) % DM; chk_put(ew, fp8d((ws + WS_WBA)[(size_t)n * DM + k]) / 64.0, a.w_ba[(size_t)k * DM + n], 1e-3, 0.08); chk_put(ew, bf2f(((const bf16*)(ws + WS_WOUT))[(size_t)n * DM + k]), a.w_out[(size_t)k * DM + n], 1e-3, 0.006); }
    } else if (stage == 7) {
        if (gid < 4096) { const int m = dbg_row(gid & 63), n = dh(gid) % DM; const bf16* y = (const bf16*)(ws + WS_XBC) + (size_t)m * D_CONV; const bf16* w1 = (const bf16*)(ws + WS_WBS) + (size_t)n * D_SSM; double s1 = 0, s2 = 0;
            for (int k = 0; k < D_SSM; ++k) s1 += (double)bf2f(y[k]) * (double)bf2f(w1[k]); const unsigned char* o = ws + WS_O + (size_t)m * DM; const unsigned char* w2 = ws + WS_WBA + (size_t)n * DM; for (int k = 0; k < DM; ++k) s2 += fp8d(o[k]) * fp8d(w2[k]) / 1024.0;
            const double g1 = bf2f(PROJ[(size_t)m * NP + PC_GSSM + n]), g2 = bf2f(PROJ[(size_t)m * NP + PC_GATT2 + n]);
            chk_put(ew, bf2f(((const bf16*)(ws + WS_MERGED))[(size_t)m * DM + n]), s1 / (1.0 + exp(-g1)) + s2 / (1.0 + exp(-g2)), 0.25, 0.012); }
    } else if (stage == 8) {
        if (gid < 4096) { const int m = dbg_row(gid & 63), n = dh(gid) % DM; const bf16* y = (const bf16*)(ws + WS_MERGED) + (size_t)m * DM; const bf16* w = (const bf16*)(ws + WS_WOUT) + (size_t)n * DM; double s = 0; for (int k = 0; k < DM; ++k) s += (double)bf2f(y[k]) * (double)bf2f(w[k]);
            chk_put(ew, bf2f(((const bf16*)(ws + WS_H16))[(size_t)m * DM + n]), s + a.x[(size_t)m * DM + n], 0.25, 0.01); }
    }
}
__global__ void dbg_scan8(Args a, const unsigned char* p, size_t n, int slot) {
    unsigned* ew = (unsigned*)(a.ws + WS_CTL) + CW_CHK + slot; bool bad = false;
    for (size_t i = ((size_t)blockIdx.x * blockDim.x + threadIdx.x) * 4; i < n; i += (size_t)gridDim.x * blockDim.x * 4) { const unsigned w = *(const unsigned*)(p + i); if ((((w & 0x7F7F7F7Fu) + 0x01010101u) & 0x80808080u) != 0u) bad = true; }
    if (bad) atomicMax(ew, __float_as_uint(1e30f));
}
__device__ __forceinline__ unsigned char dbg_i2f8(int v) { const int a = v < 0 ? -v : v; const unsigned char t[5] = {0x00, 0x38, 0x40, 0x44, 0x48}; return (unsigned char)(t[a] | (v < 0 ? 0x80 : 0)); }
__device__ __forceinline__ int dbg_Aik(int i, int k) { return ((i * 7 + k * 3 + (k >> 5)) % 5) - 2; }
__device__ __forceinline__ int dbg_Bkj(int k, int j) { return ((k * 5 + j * 11 + (k >> 4)) % 7) - 3; }
__global__ void dbg_mfma(Args a) {
    typedef int v8i_t __attribute__((ext_vector_type(8))); typedef float f4 __attribute__((ext_vector_type(4)));
    unsigned* ew = (unsigned*)(a.ws + WS_CTL) + CW_CHK + 12;
    const int l = threadIdx.x, r16 = l & 15, q = l >> 4;
    v8i_t fa, fb;
    for (int w = 0; w < 8; ++w) { unsigned wa = 0, wb = 0; for (int e = 0; e < 4; ++e) { const int k = 32 * q + 4 * w + e; wa |= (unsigned)dbg_i2f8(dbg_Aik(r16, k)) << (8 * e); wb |= (unsigned)dbg_i2f8(dbg_Bkj(k, r16)) << (8 * e); } fa[w] = (int)wa; fb[w] = (int)wb; }
    int one = 0x7F7F7F7F, s6 = 0x79797979; asm volatile("" : "+v"(one), "+v"(s6));
    f4 d1 = {0.f, 0.f, 0.f, 0.f}, d2 = {0.f, 0.f, 0.f, 0.f}, d3 = {0.f, 0.f, 0.f, 0.f};
    asm volatile("v_mfma_scale_f32_16x16x128_f8f6f4 %0, %1, %2, %0, %3, %4 op_sel_hi:[0,0,0]" : "+v"(d1) : "v"(fa), "v"(fb), "v"(one), "v"(one));
    asm volatile("v_mfma_scale_f32_16x16x128_f8f6f4 %0, %1, %2, %0, %3, %4 op_sel_hi:[0,0,0]" : "+v"(d2) : "v"(fa), "v"(fb), "v"(s6), "v"(s6));
    asm volatile("s_nop 15\n\ts_nop 15" ::: "memory");
    d3 = __builtin_amdgcn_mfma_scale_f32_16x16x128_f8f6f4(fa, fb, d3, 0, 0, 0, s6, 0, s6);
    int bits = 0;
    for (int r = 0; r < 4; ++r) { const int i = 4 * q + r, j = r16; int ref = 0; for (int k = 0; k < 128; ++k) ref += dbg_Aik(i, k) * dbg_Bkj(k, j);
        if (d1[r] != (float)ref) bits |= 1; if (d2[r] != (float)ref / 4096.0f) bits |= 2; if (d3[r] != (float)ref / 4096.0f) bits |= 4; }
    if (bits) atomicMax(ew, __float_as_uint((float)(1 << bits)));
}
__global__ void dbg_final(Args a) {
    const unsigned* ew = (const unsigned*)(a.ws + WS_CTL) + CW_CHK; const unsigned* ctl = (const unsigned*)(a.ws + WS_CTL);
    int bad = -1, cls = 0;
    const int order[12] = {12, 9, 11, 0, 1, 2, 3, 4, 5, 6, 7, 8};
    for (int si = 0; si < 12; ++si) { const int s = order[si]; const float e = __uint_as_float(ew[s]); const float tol = 1.0f; if (e > tol) { bad = s; float r = e / tol; cls = 0; while (r >= 2.f && cls < 7) { r *= 0.5f; ++cls; } break; } }
    if (bad < 0 && (ctl[CW_TMO] != 0u || ctl[CW_BAR + XB_TMO] != 0u)) { bad = 10; cls = 0; }
    if (bad < 0) return;
    const size_t n = (size_t)M * DM; for (size_t i = (size_t)blockIdx.x * blockDim.x + threadIdx.x; i < n; i += (size_t)gridDim.x * blockDim.x) a.out[i] = (i == 0) ? (float)((10 + 8 * bad + cls) * 100) : 0.f;
}
#ifndef DBG_LAST
#define DBG_LAST 9
#endif
static void dbg_run(Args a, int grid, hipStream_t stream) {
    for (int p = 0; p < NPHASE; ++p) {
        if (p == 6) hipLaunchKernelGGL(dbg_save_rows, dim3(DBG_NROW), dim3(256), 0, stream, a);
        if (p <= DBG_LAST) { a.ph_lo = p; a.ph_hi = p + 1; hipLaunchKernelGGL(mk_fwd, dim3(grid), dim3(NWAVES * 64), LDS_BYTES, stream, a); }
        if (p <= DBG_LAST && p < 9) hipLaunchKernelGGL(dbg_chk, dim3(96), dim3(256), 0, stream, a, p);
        if (p == 5) hipLaunchKernelGGL(dbg_scan8, dim3(1024), dim3(256), 0, stream, a, (const unsigned char*)a.ws + WS_O, (size_t)M * DM, 9);
        if (p == 6) hipLaunchKernelGGL(dbg_scan8, dim3(1024), dim3(256), 0, stream, a, (const unsigned char*)a.ws + WS_WBA, (size_t)DM * DM, 11);
        if (p == 0) hipLaunchKernelGGL(dbg_mfma, dim3(1), dim3(64), 0, stream, a);
    }
    hipLaunchKernelGGL(dbg_final, dim3(1024), dim3(256), 0, stream, a);
}
#endif

extern "C" void kernel_launch(void* const* d_in, const int* in_sizes, int n_in, void* d_out, int out_size, void* d_ws, size_t ws_size, hipStream_t stream) {
    static int grid = 0;
    if (grid == 0) {
        if (n_in != 17 || in_sizes[0] != M * DM || out_size != M * DM || ws_size < WS_TOTAL) { fprintf(stderr, "kernel_launch: unexpected shapes (n_in %d, ws %zu)\n", n_in, ws_size); grid = -1; return; }
        int dev = 0, cus = 0, per_cu = 0;
        if (hipGetDevice(&dev) != hipSuccess || hipDeviceGetAttribute(&cus, hipDeviceAttributeMultiprocessorCount, dev) != hipSuccess) { grid = -1; return; }
        if (hipFuncSetAttribute((const void*)mk_fwd, hipFuncAttributeMaxDynamicSharedMemorySize, LDS_BYTES) != hipSuccess) { fprintf(stderr, "kernel_launch: hipFuncSetAttribute failed\n"); grid = -1; return; }
        if (hipOccupancyMaxActiveBlocksPerMultiprocessor(&per_cu, (const void*)mk_fwd, NWAVES * 64, LDS_BYTES) != hipSuccess || per_cu < 1) { fprintf(stderr, "kernel_launch: occupancy query says %d\n", per_cu); }
        (void)hipGetLastError();
        grid = cus;
    }
    if (grid < 0) return;
    (void)hipMemsetAsync((char*)d_ws + WS_CTL, 0, CTL_ZERO_BYTES, stream);
    Args a{};
    a.x = (const float*)d_in[0]; a.norm_in_w = (const float*)d_in[1]; a.w_in = (const float*)d_in[2]; a.conv_w = (const float*)d_in[3]; a.conv_b = (const float*)d_in[4];
    a.dt_bias = (const float*)d_in[5]; a.a_log = (const float*)d_in[6]; a.d_skip = (const float*)d_in[7]; a.ssm_norm_w = (const float*)d_in[8]; a.q_norm_w = (const float*)d_in[9];
    a.w_uq = (const float*)d_in[10]; a.kv_norm_w = (const float*)d_in[11]; a.w_ukv = (const float*)d_in[12]; a.w_bs = (const float*)d_in[13]; a.w_ba = (const float*)d_in[14];
    a.w_out = (const float*)d_in[15]; a.norm_final_w = (const float*)d_in[16];
    a.out = (float*)d_out; a.ws = (unsigned char*)d_ws;
#if MK_DEBUG
    dbg_run(a, grid, stream);
#else
    a.ph_lo = 0; a.ph_hi = NPHASE;
    hipLaunchKernelGGL(mk_fwd, dim3(grid), dim3(NWAVES * 64), LDS_BYTES, stream, a);
#endif
}
```
